# Optimizing an MI355X kernel written in HIP

```python
import jax, jax.numpy as jnp
from jax import lax
import numpy as np

D_MODEL = 2048
BATCH = 1
SEQ = 16384
DEPTH = 2

GRID_W = 64
CTX_LEN = 256
N_MIXERS = 2
N_SUB = 3
POOL_WINDOWS = (2, 4, 8, 16)
N_POOL_GROUPS = len(POOL_WINDOWS)
POOL_G = D_MODEL // N_POOL_GROUPS
HGRN_EXPAND = 128
HGRN_HEADS = D_MODEL // HGRN_EXPAND
HGRN_K = HGRN_EXPAND
HGRN_V = D_MODEL // HGRN_HEADS
CHUNK = 64
D_FF = 5632
N_POOL_LAYERS = (DEPTH + 1) // 2
N_HGRN_LAYERS = DEPTH // 2
ALPHA = (2 * DEPTH) ** 0.25
BETA = (8 * DEPTH) ** -0.25
LN_EPS = 1e-5
RMS_EPS = 1e-6

kernel_name = "hybrid_pool_hgrn2_macaron_deepnorm_prefix"


def layer_norm(x, g, b):
    xf = x.astype(jnp.float32)
    mu = jnp.mean(xf, -1, keepdims=True)
    var = jnp.mean(jnp.square(xf - mu), -1, keepdims=True)
    return ((xf - mu) * lax.rsqrt(var + LN_EPS) * g + b).astype(x.dtype)


def mod_in(x, m, s):
    return x * (1 + m[..., s, 1, :][..., None, :]) + m[..., s, 0, :][..., None, :]


def residual(x, y, m, s, g, b):
    return layer_norm(ALPHA * x + m[..., s, 2, :][..., None, :] * y, g, b)


def swiglu(h, w_in, w_out):
    a, u = jnp.split(h @ w_in, 2, axis=-1)
    return (jax.nn.silu(a) * u) @ w_out


def window_mean(x, w, axis):
    n = x.shape[axis]
    cs = jnp.cumsum(x.astype(jnp.float32), axis=axis)
    pad = [(0, 0)] * x.ndim
    pad[axis] = (1, 0)
    cs = jnp.pad(cs, pad)
    idx = jnp.arange(n)
    lo = jnp.clip(idx - w // 2, 0, n)
    hi = jnp.clip(idx - w // 2 + w, 0, n)
    s = jnp.take(cs, hi, axis=axis) - jnp.take(cs, lo, axis=axis)
    shape = [1] * x.ndim
    shape[axis] = n
    cnt = (hi - lo).astype(jnp.float32).reshape(shape)
    return (s / cnt).astype(x.dtype)


def pool_mixer(h, w, scale, grid):
    b, n, d = h.shape
    if grid:
        rows = n // GRID_W
        t = h.reshape(b, rows, GRID_W, d)
    else:
        t = h
    outs = []
    for gi, win in enumerate(POOL_WINDOWS):
        xg = t[..., gi * POOL_G:(gi + 1) * POOL_G]
        if grid:
            m = window_mean(window_mean(xg, win, 1), win, 2)
        else:
            m = window_mean(xg, win, 1)
        outs.append(m - xg)
    p = jnp.stack(outs, axis=-2).reshape(b, n, N_POOL_GROUPS, POOL_G)
    y = jnp.einsum('bngc,gcd->bngd', p, w).reshape(b, n, d)
    return y * scale


def _split_heads(a):
    b, n, _ = a.shape
    return a.reshape(b, n, HGRN_HEADS, -1).transpose(0, 2, 1, 3)


def _flip(a):
    return jnp.flip(a, axis=2)


def _hgrn_gates(a, lb):
    a = _split_heads(a).astype(jnp.float32)
    lb = lb.reshape(HGRN_HEADS, 1, HGRN_K)
    log_f = jnp.logaddexp(jnp.log(lb), jnp.log1p(-lb) + jax.nn.log_sigmoid(a))
    k = (1.0 - lb) * jax.nn.sigmoid(-a)
    return k, log_f


def _hgrn_project(h, w_in, lb_f, lb_b):
    q, i, af, ab, og = jnp.split(h @ w_in, 5, axis=-1)
    q = _split_heads(jax.nn.silu(q)) * (HGRN_K ** -0.5)
    v = _split_heads(i)
    kf, gf = _hgrn_gates(af, lb_f)
    kb, gb = _hgrn_gates(ab, lb_b)
    return q, v, kf, gf, kb, gb, og


def gla_chunk_scan(q, k, v, g, s0):
    b, nh, t, _ = q.shape
    nc = t // CHUNK

    def to_chunks(a):
        return a.reshape(b, nh, nc, CHUNK, a.shape[-1]).transpose(2, 0, 1, 3, 4)

    mask = jnp.tril(jnp.ones((CHUNK, CHUNK), bool))[:, :, None]

    def step(S, inp):
        qc, kc, vc, gc = inp
        G = jnp.cumsum(gc, axis=-2)
        rel = jnp.where(mask, G[:, :, :, None, :] - G[:, :, None, :, :], -jnp.inf)
        A = jnp.einsum('bhtk,bhsk,bhtsk->bhts', qc, kc, jnp.exp(rel))
        o = jnp.einsum('bhts,bhsv->bhtv', A, vc) + jnp.einsum('bhtk,bhkv->bhtv', qc * jnp.exp(G), S)
        G_last = G[:, :, -1:, :]
        S = jnp.exp(G_last[:, :, 0, :])[..., None] * S + jnp.einsum('bhsk,bhsv->bhkv', kc * jnp.exp(G_last - G), vc)
        return S, o

    S, o = lax.scan(step, s0, (to_chunks(q), to_chunks(k), to_chunks(v), to_chunks(g)))
    o = o.transpose(1, 2, 0, 3, 4).reshape(b, nh, t, -1)
    return o, S


def gla_final_state(k, v, g):
    G = jnp.cumsum(g, axis=-2)
    return jnp.einsum('bhsk,bhsv->bhkv', k * jnp.exp(G[:, :, -1:, :] - G), v)


def _hgrn_readout(o, og, norm_g, w_out):
    b, _, n, _ = o.shape
    o = o * lax.rsqrt(jnp.mean(jnp.square(o), -1, keepdims=True) + RMS_EPS) * norm_g
    o = o.transpose(0, 2, 1, 3).reshape(b, n, D_MODEL)
    return (o * jax.nn.silu(og.astype(jnp.float32))).astype(og.dtype) @ w_out


def hgrn_mixer(h, hc, w_in, lb_f, lb_b, norm_g, w_out, ctx_out):
    b = h.shape[0]
    zero = jnp.zeros((b, HGRN_HEADS, HGRN_K, HGRN_V), jnp.float32)
    if ctx_out:
        qc, vc, kfc, gfc, kbc, gbc, ogc = _hgrn_project(hc, w_in, lb_f, lb_b)
        oc_f, s_f = gla_chunk_scan(qc, kfc, vc, gfc, zero)
        oc_b, s_b = gla_chunk_scan(_flip(qc), _flip(kbc), _flip(vc), _flip(gbc), zero)
        yc = _hgrn_readout(oc_f + _flip(oc_b), ogc, norm_g, w_out)
    else:
        ic, afc, abc = jnp.split(hc @ w_in[:, D_MODEL:4 * D_MODEL], 3, axis=-1)
        vc = _split_heads(ic)
        kfc, gfc = _hgrn_gates(afc, lb_f)
        kbc, gbc = _hgrn_gates(abc, lb_b)
        s_f = gla_final_state(kfc, vc, gfc)
        s_b = gla_final_state(_flip(kbc), _flip(vc), _flip(gbc))
        yc = None
    q, v, kf, gf, kb, gb, og = _hgrn_project(h, w_in, lb_f, lb_b)
    o_f, _ = gla_chunk_scan(q, kf, v, gf, s_f)
    o_b, _ = gla_chunk_scan(_flip(q), _flip(kb), _flip(v), _flip(gb), s_b)
    y = _hgrn_readout(o_f + _flip(o_b), og, norm_g, w_out)
    return y, yc


def setup_inputs(seed: int = 0) -> dict:
    key = jax.random.key(seed)
    ks = jax.random.split(key, 16)
    D = D_MODEL

    def nrm(k, shape, s):
        return jax.random.normal(k, shape, jnp.float32) * s

    col_scale = jnp.concatenate([jnp.ones((D,)), BETA * jnp.ones((D,)), jnp.ones((3 * D,))]).astype(jnp.float32)
    return {
        "x": nrm(ks[0], (BATCH, SEQ, D), 1.0),
        "c": nrm(ks[1], (BATCH, D), 1.0),
        "ctx": nrm(ks[2], (BATCH, CTX_LEN, D), 1.0),
        "c_ctx": nrm(ks[3], (D,), 1.0),
        "mod_w": nrm(ks[4], (DEPTH, D, N_SUB * 3 * D), 0.5 * D ** -0.5),
        "mod_b": nrm(ks[5], (DEPTH, N_SUB * 3 * D), 0.02),
        "ln_g": 1.0 + nrm(ks[6], (DEPTH, N_SUB, D), 0.02),
        "ln_b": nrm(ks[7], (DEPTH, N_SUB, D), 0.02),
        "ffn_w_in": nrm(ks[8], (DEPTH, 2, D, 2 * D_FF), BETA * D ** -0.5),
        "ffn_w_out": nrm(ks[9], (DEPTH, 2, D_FF, D), BETA * D_FF ** -0.5),
        "pool_w": nrm(ks[10], (N_POOL_LAYERS, N_POOL_GROUPS, POOL_G, POOL_G), BETA * POOL_G ** -0.5),
        "pool_scale": 1.0 + nrm(ks[11], (N_POOL_LAYERS, D), 0.02),
        "hgrn_w_in": nrm(ks[12], (N_HGRN_LAYERS, D, 5 * D), D ** -0.5) * col_scale,
        "hgrn_lb": 1.0 + nrm(ks[13], (2, DEPTH, D), 0.1),
        "hgrn_norm_g": 1.0 + nrm(ks[14], (N_HGRN_LAYERS, HGRN_V), 0.02),
        "hgrn_w_out": nrm(ks[15], (N_HGRN_LAYERS, D, D), BETA * D ** -0.5),
    }


def reference(x, c, ctx, c_ctx, mod_w, mod_b, ln_g, ln_b, ffn_w_in, ffn_w_out, pool_w, pool_scale,
              hgrn_w_in, hgrn_lb, hgrn_norm_g, hgrn_w_out):
    b = x.shape[0]
    p = jax.nn.softmax(hgrn_lb.astype(jnp.float32), axis=1)
    lower_bounds = jnp.cumsum(p, axis=1) - p[:, :1]
    sc = jax.nn.silu(c)
    sctx = jax.nn.silu(c_ctx)
    for i in range(DEPTH):
        last = i == DEPTH - 1
        kind = i % N_MIXERS
        j = i // N_MIXERS
        ctx_used = (not last) or kind == 1
        mx = (sc @ mod_w[i] + mod_b[i]).reshape(b, N_SUB, 3, D_MODEL)
        mc = (sctx @ mod_w[i] + mod_b[i]).reshape(N_SUB, 3, D_MODEL)
        x = residual(x, 0.5 * swiglu(mod_in(x, mx, 0), ffn_w_in[i, 0], ffn_w_out[i, 0]), mx, 0, ln_g[i, 0], ln_b[i, 0])
        if ctx_used:
            ctx = residual(ctx, 0.5 * swiglu(mod_in(ctx, mc, 0), ffn_w_in[i, 0], ffn_w_out[i, 0]), mc, 0, ln_g[i, 0], ln_b[i, 0])
        if kind == 0:
            y = pool_mixer(mod_in(x, mx, 1), pool_w[j], pool_scale[j], True)
            yc = None if last else pool_mixer(mod_in(ctx, mc, 1), pool_w[j], pool_scale[j], False)
        else:
            y, yc = hgrn_mixer(mod_in(x, mx, 1), mod_in(ctx, mc, 1), hgrn_w_in[j], lower_bounds[0, i],
                               lower_bounds[1, i], hgrn_norm_g[j], hgrn_w_out[j], not last)
        x = residual(x, y, mx, 1, ln_g[i, 1], ln_b[i, 1])
        if not last:
            ctx = residual(ctx, yc, mc, 1, ln_g[i, 1], ln_b[i, 1])
        x = residual(x, 0.5 * swiglu(mod_in(x, mx, 2), ffn_w_in[i, 1], ffn_w_out[i, 1]), mx, 2, ln_g[i, 2], ln_b[i, 2])
        if not last:
            ctx = residual(ctx, 0.5 * swiglu(mod_in(ctx, mc, 2), ffn_w_in[i, 1], ffn_w_out[i, 1]), mc, 2, ln_g[i, 2], ln_b[i, 2])
    return x
```

```cpp
#include <hip/hip_runtime.h>
#include <cstdio>
#include <cstdint>

namespace pg8 {
#define PG8_LAS __attribute__((address_space(3)))
typedef unsigned short bf16_t;
typedef short bf16x8 __attribute__((ext_vector_type(8)));
typedef float f32x4 __attribute__((ext_vector_type(4)));
typedef float f32x2 __attribute__((ext_vector_type(2)));
typedef unsigned u32x4 __attribute__((ext_vector_type(4)));
typedef unsigned u32x2 __attribute__((ext_vector_type(2)));
typedef short bf16x16 __attribute__((ext_vector_type(16)));
typedef int i32x8 __attribute__((ext_vector_type(8)));
typedef int i32x4 __attribute__((ext_vector_type(4)));
constexpr int BM = 256, BK = 64, HALF = 128, HTB = HALF * BK * 2, STAGE_BYTES = 8 * HTB, NXCD = 8, WGM = 8;

template <int SW = 5> __host__ __device__ __forceinline__ int lds_byte(int r, int c) { const int st = (r >> 4) * 2 + (c >> 5), rr = r & 15, cc = c & 31, ob = rr * 64 + cc * 2; return st * 1024 + (ob ^ (((ob >> 9) & 1) << SW)); }
template <int SW = 5> __host__ __device__ __forceinline__ void stage_rc(int b, int& R, int& C) { const int st = b / 1024, sb = b % 1024, swz = sb ^ (((sb >> 9) & 1) << SW); R = (st >> 1) * 16 + swz / 64; C = (st & 1) * 32 + (swz % 64) / 2; }
__host__ __device__ __forceinline__ int perm32(int rho) { const int n = rho >> 4, i = rho & 15; return 8 * (i >> 2) + 4 * n + (i & 3); }

struct Unit { int pm, pn, kt0, nt; };
struct Gemm { const void* A; const void* Bt; int lda, ldb, grp_shift, grp_bytes; };

struct StaticOrder {
    int nM, nN, nwg, G, c, ntf;
    __host__ __device__ void init(int M, int N, int K, int G_, int c_) { nM = M / BM; nN = N / BM; nwg = nM * nN; G = G_; c = c_; ntf = K / BK; }
    __host__ __device__ bool next(int i, Unit& u) const {
        const long L = (long)i * G + c; if (L >= nwg) return false;
        u.kt0 = 0; u.nt = ntf;
        int wgid = (int)L; { const int q = nwg / NXCD, r = nwg % NXCD, xcd = wgid % NXCD, off = wgid / NXCD; wgid = (xcd < r ? xcd * (q + 1) : r * (q + 1) + (xcd - r) * q) + off; }
        const int nig = WGM * nN, gid = wgid / nig, fm = gid * WGM, gsz = (nM - fm) < WGM ? (nM - fm) : WGM;
        u.pm = fm + ((wgid % nig) % gsz); u.pn = (wgid % nig) / gsz; return true;
    }
};

struct SplitCtxOrder : StaticOrder {
    int ctx_pm, nsplit, nts;
    __host__ __device__ void init2(int M, int N, int K, int G_, int c_, int ctx_pm_, int nsplit_) { init(M, N, K, G_, c_); ctx_pm = ctx_pm_; nsplit = nsplit_; nts = ntf / nsplit_; }
    __host__ __device__ bool next(int i, Unit& u) const {
        Unit a = {0, 0, 0, 0}; const bool ok = StaticOrder::next(i, a);
        const long e = (long)i * G + c - nwg; const bool ok2 = (e >= 0) && (e < (long)nN * nsplit);
        const int en = ok2 ? (int)e : 0;
        u.pm = ok ? a.pm : ctx_pm; u.pn = ok ? a.pn : (en % nN); u.kt0 = ok ? 0 : (en / nN) * nts; u.nt = ok ? ntf : nts;
        return ok || ok2;
    }
};

typedef __bf16 bf16x2_t __attribute__((ext_vector_type(2)));
__device__ __forceinline__ unsigned cvt_pk_bf16(float lo, float hi) { const f32x2 v = {lo, hi}; return __builtin_bit_cast(unsigned, __builtin_convertvector(v, bf16x2_t)); }
__device__ __forceinline__ float fsilu(float x) { return x * __builtin_amdgcn_rcpf(1.0f + __builtin_amdgcn_exp2f(-1.4426950408889634f * x)); }
__device__ __forceinline__ float fsigm(float x) { return __builtin_amdgcn_rcpf(1.0f + __builtin_amdgcn_exp2f(-1.4426950408889634f * x)); }


__device__ __forceinline__ unsigned cvt4_fp8(float a, float b, float c, float d) { int r = __builtin_amdgcn_cvt_pk_fp8_f32(a, b, 0, false); r = __builtin_amdgcn_cvt_pk_fp8_f32(c, d, r, true); return (unsigned)r; }
template <bool F8IN, bool F8> struct EpiSwiglu {
    static constexpr bool PERM = true;
    static constexpr float IN_SCALE = F8IN ? (1.0f / 64.0f) : 1.0f, OUT_SCALE = F8 ? 16.0f : 1.0f;
    void* O; int ldo;
    __device__ __forceinline__ u32x2 hid8(const f32x4 a0, const f32x4 a1, const f32x4 u0, const f32x4 u1) const {
        constexpr float KS = 1.0f / (IN_SCALE * IN_SCALE * OUT_SCALE), C1 = -1.4426950408889634f * IN_SCALE;
        const f32x4 t0 = a0 * C1, t1 = a1 * C1;
        const f32x4 e0 = {__builtin_amdgcn_exp2f(t0[0]), __builtin_amdgcn_exp2f(t0[1]), __builtin_amdgcn_exp2f(t0[2]), __builtin_amdgcn_exp2f(t0[3])};
        const f32x4 e1 = {__builtin_amdgcn_exp2f(t1[0]), __builtin_amdgcn_exp2f(t1[1]), __builtin_amdgcn_exp2f(t1[2]), __builtin_amdgcn_exp2f(t1[3])};
        const f32x4 d0 = e0 * KS + KS, d1 = e1 * KS + KS;
        const f32x4 r0 = {__builtin_amdgcn_rcpf(d0[0]), __builtin_amdgcn_rcpf(d0[1]), __builtin_amdgcn_rcpf(d0[2]), __builtin_amdgcn_rcpf(d0[3])};
        const f32x4 r1 = {__builtin_amdgcn_rcpf(d1[0]), __builtin_amdgcn_rcpf(d1[1]), __builtin_amdgcn_rcpf(d1[2]), __builtin_amdgcn_rcpf(d1[3])};
        const f32x4 h0 = (a0 * u0) * r0, h1 = (a1 * u1) * r1;
        u32x2 w; w.x = cvt4_fp8(h0[0], h0[1], h0[2], h0[3]); w.y = cvt4_fp8(h1[0], h1[1], h1[2], h1[3]); return w;
    }
    __device__ __forceinline__ void operator()(const f32x4 (&acc)[2][2][4][2], const Unit& u, int wr, int wc, int fr, int fq) const {
        const int row0 = u.pm * BM + wr * 64 + fr, col0 = u.pn * HALF + wc * 32 + 8 * fq;
        if constexpr (F8) {
            unsigned char* base = (unsigned char*)O + (size_t)(row0 + (fq & 1) * 16) * ldo + (col0 - 8 * (fq & 1));
#pragma unroll
            for (int ai = 0; ai < 2; ++ai)
#pragma unroll
                for (int mp = 0; mp < 2; ++mp) {
                    const u32x2 wa = hid8(acc[ai][0][2 * mp][0], acc[ai][0][2 * mp][1], acc[ai][1][2 * mp][0], acc[ai][1][2 * mp][1]);
                    const u32x2 wb = hid8(acc[ai][0][2 * mp + 1][0], acc[ai][0][2 * mp + 1][1], acc[ai][1][2 * mp + 1][0], acc[ai][1][2 * mp + 1][1]);
                    const auto sx = __builtin_amdgcn_permlane16_swap(wa.x, wb.x, false, false), sy = __builtin_amdgcn_permlane16_swap(wa.y, wb.y, false, false);
                    u32x4 w; w.x = sx[0]; w.y = sy[0]; w.z = sx[1]; w.w = sy[1];
                    *(u32x4*)(base + (size_t)(ai * HALF + mp * 32) * ldo) = w;
                }
        } else {
#pragma unroll
            for (int ai = 0; ai < 2; ++ai)
#pragma unroll
                for (int m = 0; m < 4; ++m) {
                    constexpr float KS = 1.0f / (IN_SCALE * IN_SCALE * OUT_SCALE), C1 = -1.4426950408889634f * IN_SCALE;
                    const f32x4 a0 = acc[ai][0][m][0], a1 = acc[ai][0][m][1], u0 = acc[ai][1][m][0], u1 = acc[ai][1][m][1];
                    float h0[4], h1[4];
#pragma unroll
                    for (int j = 0; j < 4; ++j) { h0[j] = (a0[j] * u0[j]) * __builtin_amdgcn_rcpf(KS + KS * __builtin_amdgcn_exp2f(a0[j] * C1)); h1[j] = (a1[j] * u1[j]) * __builtin_amdgcn_rcpf(KS + KS * __builtin_amdgcn_exp2f(a1[j] * C1)); }
                    bf16_t* rowp = (bf16_t*)O + (size_t)(row0 + ai * HALF + m * 16) * ldo + col0;
                    u32x4 w; w.x = cvt_pk_bf16(h0[0], h0[1]); w.y = cvt_pk_bf16(h0[2], h0[3]); w.z = cvt_pk_bf16(h1[0], h1[1]); w.w = cvt_pk_bf16(h1[2], h1[3]);
                    *(u32x4*)rowp = w;
                }
        }
    }
};

typedef _Float16 f16x8 __attribute__((ext_vector_type(8)));
typedef _Float16 f16x4 __attribute__((ext_vector_type(4)));
template <int COEF_HALVES, int ACC_SHIFT = 0, bool ZPF32 = false> struct EpiResid {
    static constexpr bool PERM = true;
    static constexpr float coefs = 0.5f * COEF_HALVES / (float)(1 << ACC_SHIFT), alpha = 1.4142135623730951f; static constexpr int ld = 2048;
    const void* zp_lat; const void* zp_ctx;
    int ctx_pm;
    const float* rs;
    const float* lg; const float* lb;
    const float* gate_lat; const float* gate_ctx;
    const float* coefv;
    _Float16* zout;
    __device__ __forceinline__ void operator()(const f32x4 (&acc)[2][2][4][2], const Unit& u, int wr, int wc, int fr, int fq) const {
        const bool isctx = (u.pm == ctx_pm);
        const char* zp = (const char*)(isctx ? zp_ctx : zp_lat) - (isctx ? (size_t)ctx_pm * BM * ld * (ZPF32 ? 4 : 2) : 0);
        const float* gate = isctx ? gate_ctx : gate_lat;
        const int row0 = u.pm * BM + wr * 64 + fr, col0 = u.pn * BM + wc * 32 + 8 * fq;
        constexpr int RD = ZPF32 ? 2 : 3;
        f32x4 zf[ZPF32 ? RD : 1][2]; f16x8 zh[ZPF32 ? 1 : RD]; f32x2 st[RD];
#define ER_LOAD(j_, b_) do { const int r_ = row0 + (((j_) >> 2) & 1) * HALF + ((j_) & 3) * 16; const size_t off_ = (size_t)r_ * ld + col0 + ((j_) >> 3) * HALF; st[b_] = *(const f32x2*)(rs + 2 * (size_t)r_); \
            if constexpr (ZPF32) { zf[b_][0] = *(const f32x4*)((const float*)zp + off_); zf[b_][1] = *(const f32x4*)((const float*)zp + off_ + 4); } else zh[b_] = __builtin_nontemporal_load((const f16x8*)((const _Float16*)zp + off_)); } while (0)
#pragma unroll
        for (int j = 0; j < RD; ++j) ER_LOAD(j, j);
        f32x4 lgA[2], lbA[2], gc[2];
#pragma unroll
        for (int j = 0; j < 16; ++j) { const int b = j % RD, bj = j >> 3, ai = (j >> 2) & 1, m = j & 3; const size_t off = (size_t)(row0 + ai * HALF + m * 16) * ld + col0 + bj * HALF;
            if ((j & 7) == 0) {
#pragma unroll
                for (int n = 0; n < 2; ++n) { const int c = col0 + bj * HALF + n * 4;
                    lgA[n] = *(const f32x4*)(lg + c) * alpha; lbA[n] = *(const f32x4*)(lb + c) * alpha;
                    f32x4 g = *(const f32x4*)(gate + c) * coefs; if (coefv) g = g * *(const f32x4*)(coefv + c); gc[n] = g; } }
            asm volatile("" ::: "memory"); __builtin_amdgcn_sched_barrier(0);
            f32x4 z0, z1;
            if constexpr (ZPF32) { z0 = zf[b][0]; z1 = zf[b][1]; }
            else { const f16x8 h = zh[b]; z0 = (f32x4){(float)h[0], (float)h[1], (float)h[2], (float)h[3]}; z1 = (f32x4){(float)h[4], (float)h[5], (float)h[6], (float)h[7]}; }
            const f32x4 o0 = ((z0 - st[b].x) * st[b].y) * lgA[0] + lbA[0] + gc[0] * acc[ai][bj][m][0];
            const f32x4 o1 = ((z1 - st[b].x) * st[b].y) * lgA[1] + lbA[1] + gc[1] * acc[ai][bj][m][1];
            const f16x8 oh = {(_Float16)o0[0], (_Float16)o0[1], (_Float16)o0[2], (_Float16)o0[3], (_Float16)o1[0], (_Float16)o1[1], (_Float16)o1[2], (_Float16)o1[3]};
            *(f16x8*)(zout + off) = oh;
            asm volatile("" ::: "memory"); __builtin_amdgcn_sched_barrier(0);
            if (j + RD < 16) ER_LOAD(j + RD, b);
        }
#undef ER_LOAD
    }
};

template <int COEF_HALVES, int ACC_SHIFT = 0, bool ZPF32 = false> struct EpiResidSplit {
    static constexpr bool PERM = true;
    EpiResid<COEF_HALVES, ACC_SHIFT, ZPF32> full; float* slab; int ntf;
    __device__ __forceinline__ void operator()(const f32x4 (&acc)[2][2][4][2], const Unit& u, int wr, int wc, int fr, int fq) const {
        if (u.nt == ntf) { full(acc, u, wr, wc, fr, fq); return; }
        float* sp = slab + (size_t)(u.kt0 / u.nt) * BM * 2048 + (size_t)(wr * 64 + fr) * 2048 + u.pn * BM + wc * 32 + 8 * fq;
#pragma unroll
        for (int ai = 0; ai < 2; ++ai)
#pragma unroll
            for (int m = 0; m < 4; ++m)
#pragma unroll
                for (int bj = 0; bj < 2; ++bj)
#pragma unroll
                    for (int n = 0; n < 2; ++n) *(f32x4*)(sp + (size_t)(ai * HALF + m * 16) * 2048 + bj * HALF + n * 4) = acc[ai][bj][m][n];
    }
};

struct EpiHgrn {
    static constexpr bool PERM = true;
    bf16_t* Q; bf16_t* V; unsigned short* GF; unsigned short* GB; bf16_t* OG; const float* lbraw;
    int ld;
    __device__ __forceinline__ void operator()(const f32x4 (&acc)[2][2][4][2], const Unit& u, int wr, int wc, int fr, int fq) const {
        const int sec = u.pn >> 3, colt = (u.pn & 7) * BM;
        const int row0 = u.pm * BM + wr * 64 + fr, col0 = colt + wc * 32 + 8 * fq;
        if (sec == 2 || sec == 3) {
            unsigned short* G = (sec == 2) ? GF : GB; const float* l0 = lbraw + (sec - 2) * 4096;
            f32x4 lbv[2][2];
#pragma unroll
            for (int bj = 0; bj < 2; ++bj)
#pragma unroll
                for (int n = 0; n < 2; ++n) { const int c = col0 + bj * HALF + 4 * n; const f32x4 a = *(const f32x4*)(l0 + c), b = *(const f32x4*)(l0 + 2048 + c);
#pragma unroll
                    for (int j = 0; j < 4; ++j) lbv[bj][n][j] = fsigm(b[j] - a[j]); }
#pragma unroll
            for (int ai = 0; ai < 2; ++ai)
#pragma unroll
                for (int m = 0; m < 4; ++m) { unsigned short* rowp = G + (size_t)(row0 + ai * HALF + m * 16) * ld + col0;
#pragma unroll
                    for (int bj = 0; bj < 2; ++bj) { _Float16 hv[8];
#pragma unroll
                        for (int n = 0; n < 2; ++n)
#pragma unroll
                            for (int j = 0; j < 4; ++j) { const float lbx = lbv[bj][n][j];
                                hv[n * 4 + j] = (_Float16)((1.0f - lbx) * fsigm(-acc[ai][bj][m][n][j])); }
                        u32x4 w;
                        w.x = (unsigned)__builtin_bit_cast(unsigned short, hv[0]) | ((unsigned)__builtin_bit_cast(unsigned short, hv[1]) << 16);
                        w.y = (unsigned)__builtin_bit_cast(unsigned short, hv[2]) | ((unsigned)__builtin_bit_cast(unsigned short, hv[3]) << 16);
                        w.z = (unsigned)__builtin_bit_cast(unsigned short, hv[4]) | ((unsigned)__builtin_bit_cast(unsigned short, hv[5]) << 16);
                        w.w = (unsigned)__builtin_bit_cast(unsigned short, hv[6]) | ((unsigned)__builtin_bit_cast(unsigned short, hv[7]) << 16);
                        *(u32x4*)(rowp + bj * HALF) = w; } }
        } else {
            bf16_t* O = (sec == 0) ? Q : (sec == 1 ? V : OG);
            const float sc = (sec == 0) ? 0.08838834764831845f : 1.0f;
#pragma unroll
            for (int ai = 0; ai < 2; ++ai)
#pragma unroll
                for (int m = 0; m < 4; ++m) { bf16_t* rowp = O + (size_t)(row0 + ai * HALF + m * 16) * ld + col0;
#pragma unroll
                    for (int bj = 0; bj < 2; ++bj) { f32x4 v0 = acc[ai][bj][m][0], v1 = acc[ai][bj][m][1];
                        if (sec != 1) {
#pragma unroll
                            for (int j = 0; j < 4; ++j) { v0[j] = fsilu(v0[j]) * sc; v1[j] = fsilu(v1[j]) * sc; } }
                        u32x4 w; w.x = cvt_pk_bf16(v0[0], v0[1]); w.y = cvt_pk_bf16(v0[2], v0[3]); w.z = cvt_pk_bf16(v1[0], v1[1]); w.w = cvt_pk_bf16(v1[2], v1[3]);
                        *(u32x4*)(rowp + bj * HALF) = w; } }
        }
    }
};

template <class Epi, class Sched, bool F8 = false, bool ALIGN_EPI = true>
__device__ __forceinline__ void gemm_phase(PG8_LAS unsigned char* lds, const Gemm g, const Sched S, const Epi E) {
    const int tid = threadIdx.x, wid = __builtin_amdgcn_readfirstlane(tid >> 6), lane = tid & 63, wr = wid >> 2, wc = wid & 3, fr = lane & 15, fq = lane >> 4;
    unsigned voffA[2], voffB[2];
#pragma unroll
    for (int i = 0; i < 2; ++i) { int R, C; stage_rc<F8 ? 4 : 5>(tid * 16 + i * 8192, R, C); const int Rb = Epi::PERM ? ((R & ~31) + perm32(R & 31)) : R;
        voffA[i] = (unsigned)(R * g.lda + C * 2); voffB[i] = (unsigned)(Rb * g.ldb + C * 2); }
    const size_t kstep = (size_t)(BK * 2);
    const size_t hstepA = (size_t)HALF * g.lda, hstepB = (size_t)HALF * g.ldb;
    const size_t tstepA = 2 * hstepA, tstepB = 2 * hstepB;
    const unsigned ldsw = (unsigned)wid * 1024u;
    const int aoff = lds_byte(wr * 64 + fr, fq * 8), boff = lds_byte(wc * 32 + fr, fq * 8);
    const int aoff8a = lds_byte<4>(wr * 64 + fr, fq * 16), aoff8b = lds_byte<4>(wr * 64 + fr, fq * 16 + 8), boff8a = lds_byte<4>(wc * 32 + fr, fq * 16), boff8b = lds_byte<4>(wc * 32 + fr, fq * 16 + 8);
#define PG8_SA(b, h) (((b) * 2 + (h)) * HTB)
#define PG8_SB(b, h) ((4 + (b) * 2 + (h)) * HTB)
#define PG8_STAGE(bufoff, gbase, voff) do { _Pragma("unroll") for (int _i = 0; _i < 2; ++_i) \
        __builtin_amdgcn_global_load_lds((const unsigned*)((const char*)(gbase) + (voff)[_i]), (PG8_LAS unsigned*)(lds + (bufoff) + ldsw + _i * 8192), 16, 0, 0); } while (0)
#define PG8_LDA(dst, b, h) do { if constexpr (F8) { _Pragma("unroll") for (int m = 0; m < 4; ++m) { dst[m][0] = *(const PG8_LAS bf16x8*)(lds + PG8_SA(b, h) + aoff8a + m * 2048); dst[m][1] = *(const PG8_LAS bf16x8*)(lds + PG8_SA(b, h) + aoff8b + m * 2048); } } \
        else { _Pragma("unroll") for (int m = 0; m < 4; ++m) _Pragma("unroll") for (int k = 0; k < 2; ++k) dst[m][k] = *(const PG8_LAS bf16x8*)(lds + PG8_SA(b, h) + aoff + m * 2048 + k * 1024); } } while (0)
#define PG8_LDB(dst, b, h) do { if constexpr (F8) { _Pragma("unroll") for (int n = 0; n < 2; ++n) { dst[n][0] = *(const PG8_LAS bf16x8*)(lds + PG8_SB(b, h) + boff8a + n * 2048); dst[n][1] = *(const PG8_LAS bf16x8*)(lds + PG8_SB(b, h) + boff8b + n * 2048); } } \
        else { _Pragma("unroll") for (int n = 0; n < 2; ++n) _Pragma("unroll") for (int k = 0; k < 2; ++k) dst[n][k] = *(const PG8_LAS bf16x8*)(lds + PG8_SB(b, h) + boff + n * 2048 + k * 1024); } } while (0)
#define PG8_F8FRAG(x) __builtin_shufflevector(__builtin_bit_cast(i32x4, x[0]), __builtin_bit_cast(i32x4, x[1]), 0, 1, 2, 3, 4, 5, 6, 7)
#define PG8_MMA(ai, bj, At, Bt) do { __builtin_amdgcn_s_setprio(1); if constexpr (F8) { _Pragma("unroll") for (int m = 0; m < 4; ++m) _Pragma("unroll") for (int n = 0; n < 2; ++n) \
            asm volatile("v_mfma_scale_f32_16x16x128_f8f6f4 %0, %1, %2, %0, %3, %3 op_sel_hi:[0,0,0]" : "+v"(acc[ai][bj][m][n]) : "v"(PG8_F8FRAG(Bt[n])), "v"(PG8_F8FRAG(At[m])), "v"(sc_one)); } \
        else { _Pragma("unroll") for (int m = 0; m < 4; ++m) _Pragma("unroll") for (int n = 0; n < 2; ++n) _Pragma("unroll") for (int k = 0; k < 2; ++k) \
            acc[ai][bj][m][n] = __builtin_amdgcn_mfma_f32_16x16x32_bf16(Bt[n][k], At[m][k], acc[ai][bj][m][n], 0, 0, 0); } __builtin_amdgcn_s_setprio(0); } while (0)
#define PG8_WAIT_V(n) asm volatile("s_waitcnt vmcnt(" #n ")" ::: "memory")
#define PG8_WAIT_L(n) asm volatile("s_waitcnt lgkmcnt(" #n ")" ::: "memory")
#define PG8_BAR __builtin_amdgcn_s_barrier()
#define PG8_SCHED __builtin_amdgcn_sched_barrier(0)
    Unit cur, nxt; int ui = 0;
    if (!S.next(0, cur)) return;
    int sc_one = 0x7f7f7f7f; asm volatile("" : "+v"(sc_one));
    (void)sc_one;
    f32x4 acc[2][2][4][2];
#pragma unroll
    for (int a = 0; a < 2; ++a)
#pragma unroll
        for (int b = 0; b < 2; ++b)
#pragma unroll
            for (int m = 0; m < 4; ++m)
#pragma unroll
                for (int n = 0; n < 2; ++n) acc[a][b][m][n] = (f32x4){0.f, 0.f, 0.f, 0.f};
    bf16x8 At[4][2], B0[2][2], B1[2][2];
    const char* cA = (const char*)g.A + (size_t)cur.pm * tstepA + (size_t)((cur.pn >> g.grp_shift) * g.grp_bytes) + (size_t)cur.kt0 * kstep; const char* cB = (const char*)g.Bt + (size_t)cur.pn * tstepB + (size_t)cur.kt0 * kstep;
    PG8_STAGE(PG8_SB(0, 0), cB, voffB); PG8_STAGE(PG8_SB(0, 1), cB + hstepB, voffB); PG8_STAGE(PG8_SA(0, 0), cA, voffA); PG8_STAGE(PG8_SA(0, 1), cA + hstepA, voffA);
    if (wr == 1) PG8_BAR;
    PG8_WAIT_V(2); PG8_BAR;
    PG8_STAGE(PG8_SB(1, 0), cB + kstep, voffB); PG8_STAGE(PG8_SA(1, 0), cA + kstep, voffA); PG8_STAGE(PG8_SB(1, 1), cB + hstepB + kstep, voffB);
    PG8_WAIT_V(6); PG8_BAR;
    for (;;) {
        const bool has_next = S.next(ui + 1, nxt);
        const char* nA = has_next ? (const char*)g.A + (size_t)nxt.pm * tstepA + (size_t)((nxt.pn >> g.grp_shift) * g.grp_bytes) + (size_t)nxt.kt0 * kstep : cA; const char* nB = has_next ? (const char*)g.Bt + (size_t)nxt.pn * tstepB + (size_t)nxt.kt0 * kstep : cB;
        const int nt = cur.nt;
        for (int t = 0; t < nt; t += 2) {
            const bool last = (t == nt - 2);
            const char* a1 = cA + (size_t)(t + 1) * kstep;
            const char* a2 = last ? nA : cA + (size_t)(t + 2) * kstep; const char* b2 = last ? nB : cB + (size_t)(t + 2) * kstep;
            const char* a3 = a2 + kstep; const char* b3 = b2 + kstep;
            PG8_LDB(B0, 0, 0); PG8_LDB(B1, 0, 1); PG8_SCHED; PG8_LDA(At, 0, 0); PG8_STAGE(PG8_SA(1, 1), a1 + hstepA, voffA);
            PG8_WAIT_V(8); PG8_WAIT_L(0); PG8_BAR; PG8_MMA(0, 0, At, B0); PG8_MMA(0, 1, At, B1); PG8_BAR; PG8_SCHED;
            PG8_LDA(At, 0, 1); PG8_STAGE(PG8_SB(0, 0), b2, voffB); PG8_STAGE(PG8_SB(0, 1), b2 + hstepB, voffB); PG8_STAGE(PG8_SA(0, 0), a2, voffA);
            PG8_WAIT_V(8); PG8_WAIT_L(0); PG8_BAR; PG8_MMA(1, 0, At, B0); PG8_MMA(1, 1, At, B1); PG8_BAR; PG8_SCHED;
            PG8_LDB(B0, 1, 0); PG8_LDB(B1, 1, 1); PG8_SCHED; PG8_LDA(At, 1, 0); PG8_STAGE(PG8_SA(0, 1), a2 + hstepA, voffA);
            PG8_WAIT_V(8); PG8_WAIT_L(0); PG8_BAR; PG8_MMA(0, 0, At, B0); PG8_MMA(0, 1, At, B1); PG8_BAR; PG8_SCHED;
            PG8_LDA(At, 1, 1); PG8_STAGE(PG8_SB(1, 0), b3, voffB); PG8_STAGE(PG8_SB(1, 1), b3 + hstepB, voffB); PG8_STAGE(PG8_SA(1, 0), a3, voffA);
            PG8_WAIT_V(8); PG8_WAIT_L(0); PG8_BAR; PG8_MMA(1, 0, At, B0); PG8_MMA(1, 1, At, B1); PG8_BAR; PG8_SCHED;
        }
        if constexpr (ALIGN_EPI) { if (wr == 0) PG8_BAR; }
        if constexpr (F8) {
            asm volatile("s_nop 15\n\ts_nop 15" : "+v"(acc[0][0][0][0]), "+v"(acc[0][0][0][1]), "+v"(acc[0][0][1][0]), "+v"(acc[0][0][1][1]), "+v"(acc[0][0][2][0]), "+v"(acc[0][0][2][1]), "+v"(acc[0][0][3][0]), "+v"(acc[0][0][3][1]),
                         "+v"(acc[0][1][0][0]), "+v"(acc[0][1][0][1]), "+v"(acc[0][1][1][0]), "+v"(acc[0][1][1][1]), "+v"(acc[0][1][2][0]), "+v"(acc[0][1][2][1]), "+v"(acc[0][1][3][0]), "+v"(acc[0][1][3][1]));
            asm volatile("" : "+v"(acc[1][0][0][0]), "+v"(acc[1][0][0][1]), "+v"(acc[1][0][1][0]), "+v"(acc[1][0][1][1]), "+v"(acc[1][0][2][0]), "+v"(acc[1][0][2][1]), "+v"(acc[1][0][3][0]), "+v"(acc[1][0][3][1]),
                         "+v"(acc[1][1][0][0]), "+v"(acc[1][1][0][1]), "+v"(acc[1][1][1][0]), "+v"(acc[1][1][1][1]), "+v"(acc[1][1][2][0]), "+v"(acc[1][1][2][1]), "+v"(acc[1][1][3][0]), "+v"(acc[1][1][3][1]));
        }
        E(acc, cur, wr, wc, fr, fq);
        if (!has_next) break;
#pragma unroll
        for (int a = 0; a < 2; ++a)
#pragma unroll
            for (int b = 0; b < 2; ++b)
#pragma unroll
                for (int m = 0; m < 4; ++m)
#pragma unroll
                    for (int n = 0; n < 2; ++n) acc[a][b][m][n] = (f32x4){0.f, 0.f, 0.f, 0.f};
        cur = nxt; cA = nA; cB = nB; ++ui;
        if constexpr (ALIGN_EPI) { if (wr == 1) PG8_BAR; }
    }
    PG8_WAIT_V(0);
    if constexpr (!ALIGN_EPI) { if (wr == 0) PG8_BAR; }
    PG8_BAR;
#undef PG8_SA
#undef PG8_SB
#undef PG8_STAGE
#undef PG8_LDA
#undef PG8_LDB
#undef PG8_MMA
#undef PG8_F8FRAG
#undef PG8_WAIT_V
#undef PG8_WAIT_L
#undef PG8_BAR
#undef PG8_SCHED
}
}

constexpr int D = 2048, SEQ = 16384, CTXL = 256, MALL = SEQ + CTXL, DFF = 5632, NMOD = 9 * D;
constexpr int HH = 16, HK = 128, NSEG = 16, SEGLEN = SEQ / NSEG, CHUNK = 64;
constexpr float LN_EPS = 1e-5f, RMS_EPS = 1e-6f, ALPHA = 1.4142135623730951f;
constexpr int NWAVES = 8, NTHREADS = 512;

constexpr size_t MiB = 1u << 20;
constexpr size_t WS_CTL = 0, CTL_ZERO_BYTES = 2 * MiB;
constexpr size_t WS_MOD = 1 * MiB;
constexpr size_t WS_VEC = 2 * MiB;
constexpr size_t WS_RS = 3 * MiB;
constexpr size_t WS_WPT = 4 * MiB, WS_WHO = 6 * MiB, WS_WHI = 14 * MiB, WS_W2T = 54 * MiB, WS_W1T = 142 * MiB;
constexpr size_t WS_ZA = 318 * MiB, WS_ZB = 448 * MiB, WS_H = 578 * MiB, WS_HID = 643 * MiB;
constexpr size_t WS_Q = 822 * MiB, WS_V = 887 * MiB, WS_OG = 952 * MiB, WS_GF = 1017 * MiB, WS_GB = 1082 * MiB;
constexpr size_t WS_ST = 1147 * MiB;
constexpr size_t WS_CST = 1179 * MiB;
constexpr size_t WS_DT = 1181 * MiB;
constexpr size_t WS_SLAB = 1182 * MiB;
constexpr size_t WS_END = 1240 * MiB;
constexpr int NSPLIT = 11;
constexpr int MOD1_CUT = 48 * 2048;
#ifndef MK_F8_IN
#define MK_F8_IN 1
#endif
#ifndef MK_F8_OUT
#define MK_F8_OUT 1
#endif
constexpr bool F8_IN = MK_F8_IN, F8_OUT = MK_F8_OUT;
constexpr float COMB_SCALE = F8_OUT ? (0.5f / 2048.0f) : 0.5f;
constexpr size_t WS_H8 = 1204 * MiB;
#undef WS_END_PLACEHOLDER
constexpr size_t W1T_STRIDE = (size_t)2 * DFF * D, W2T_STRIDE = (size_t)D * DFF;
constexpr int CW_BAR = 4096;

constexpr int RING_OFF = 0, RING_BYTES = 131072;
constexpr int SVEC_OFF = RING_BYTES;
constexpr int MISC_OFF = SVEC_OFF + 16384;
constexpr int LDS_BYTES = MISC_OFF + 1024;

#define GAS __attribute__((address_space(1)))
#define LAS __attribute__((address_space(3)))
typedef unsigned short bf16;
typedef unsigned v4u __attribute__((ext_vector_type(4)));
typedef unsigned v2u __attribute__((ext_vector_type(2)));
typedef float f32x4 __attribute__((ext_vector_type(4)));
typedef float f32x2 __attribute__((ext_vector_type(2)));
typedef short bf16x8 __attribute__((ext_vector_type(8)));
typedef short bf16x4 __attribute__((ext_vector_type(4)));
typedef GAS unsigned gu32;
#define LDS_WAIT() asm volatile("s_waitcnt lgkmcnt(0)" ::: "memory")
#define VM_WAIT() asm volatile("s_waitcnt vmcnt(0)" ::: "memory")
__device__ __forceinline__ unsigned f2bf(float f) { unsigned u = __builtin_bit_cast(unsigned, f); return (u + 0x7fffu + ((u >> 16) & 1u)) >> 16; }
__device__ __forceinline__ unsigned pk2(float lo, float hi) { return pg8::cvt_pk_bf16(lo, hi); }
__device__ __forceinline__ float bf2f(unsigned short b) { return __builtin_bit_cast(float, ((unsigned)b) << 16); }
__device__ __forceinline__ float fexp(float x) { return __builtin_amdgcn_exp2f(1.4426950408889634f * x); }

#define XB_TMO      128
#define XB_XCNT(j)  (256  + 64 * (j))
#define XB_XSUB(j)  (1280 + 64 * (j))
#define XB_XGEN(j)  (2304 + 64 * (j))
#define XB_TOP      3328
#define XB_TOPGEN   3392
#define XCD_BAR_WORDS 3456
#define XB_SPIN_CAP (1u << 18)
__device__ __forceinline__ unsigned xb_ld(unsigned* p)              { return __hip_atomic_load(p, __ATOMIC_RELAXED, __HIP_MEMORY_SCOPE_AGENT); }
__device__ __forceinline__ unsigned xb_add(unsigned* p, unsigned v) { return __hip_atomic_fetch_add(p, v, __ATOMIC_RELAXED, __HIP_MEMORY_SCOPE_AGENT); }
__device__ __forceinline__ unsigned xb_xcc_id() { return (unsigned)__builtin_amdgcn_s_getreg((3 << 11) | 20) & 0xFu; }
#define XB_SPIN(cond, bar) do { unsigned _sp = 0; while (cond) { __builtin_amdgcn_s_sleep(1); \
    if ((++_sp & 255u) == 0u) { if (xb_ld(&(bar)[XB_TMO])) break; if (_sp > XB_SPIN_CAP) { atomicAdd(&(bar)[XB_TMO], 1u); break; } } } } while (0)
struct XcdBarrier { unsigned* bar; unsigned x; volatile LAS unsigned* st; };
__device__ __forceinline__ XcdBarrier xcd_barrier_post(unsigned* bar, volatile LAS unsigned* st) {
    XcdBarrier b; b.bar = bar; b.x = xb_xcc_id(); b.st = st;
    if (threadIdx.x == 0) (void)xb_add(&bar[XB_XCNT(b.x)], 1u);
    return b;
}
__device__ __forceinline__ void xcd_barrier_complete(unsigned* bar, unsigned x, unsigned& nloc, unsigned& nx) {
    const unsigned G = gridDim.x * gridDim.y * gridDim.z;
    unsigned sum, cnt, mine, sp = 0u;
    for (;;) {
        sum = 0u; cnt = 0u; mine = 0u;
#pragma unroll
        for (unsigned j = 0; j < 16; ++j) { const unsigned c = xb_ld(&bar[XB_XCNT(j)]); sum += c; cnt += (c > 0u) ? 1u : 0u; mine = (j == x) ? c : mine; }
        if (sum == G) break;
        __builtin_amdgcn_s_sleep(1);
        if ((++sp & 255u) == 0u) { if (xb_ld(&bar[XB_TMO])) break; if (sp > XB_SPIN_CAP) { atomicAdd(&bar[XB_TMO], 1u); break; } }
    }
    nloc = mine > 0u ? mine : 1u; nx = cnt > 0u ? cnt : 1u;
}
__device__ __forceinline__ void xcd_barrier(const XcdBarrier& b) {
    asm volatile("s_waitcnt vmcnt(0)" ::: "memory");
    __syncthreads();
    if (threadIdx.x == 0) {
        unsigned* bar = b.bar;
        __builtin_amdgcn_s_waitcnt(0);
        unsigned nloc = b.st[0], nx = b.st[1];
        if (nloc == 0u) { xcd_barrier_complete(bar, b.x, nloc, nx); b.st[0] = nloc; b.st[1] = nx; }
        const unsigned old = xb_add(&bar[XB_XSUB(b.x)], 1u);
        const unsigned gen = old / nloc;
        if (old + 1u == (gen + 1u) * nloc) {
            __builtin_amdgcn_fence(__ATOMIC_RELEASE, "agent");
            asm volatile("s_waitcnt vmcnt(0)" ::: "memory");
            const unsigned og = xb_add(&bar[XB_TOP], 1u);
            const unsigned tg = og / nx;
            if (og + 1u == (tg + 1u) * nx) xb_add(&bar[XB_TOPGEN], 1u);
            else XB_SPIN(xb_ld(&bar[XB_TOPGEN]) == tg, bar);
            __builtin_amdgcn_fence(__ATOMIC_ACQUIRE, "agent");
            xb_add(&bar[XB_XGEN(b.x)], 1u);
            asm volatile("s_waitcnt vmcnt(0)" ::: "memory");
        } else {
            XB_SPIN(xb_ld(&bar[XB_XGEN(b.x)]) == gen, bar);
            __builtin_amdgcn_fence(__ATOMIC_ACQUIRE, "agent");
            asm volatile("s_waitcnt vmcnt(0)" ::: "memory");
        }
    }
    __syncthreads();
}

struct Frame {
    LAS unsigned char* lds;
    int tid, lane, wave, G, gw, NGW;
    const float* in[16]; float* out; unsigned char* ws;
};
__device__ __forceinline__ float wave_sum(float v) {
#define WS_ROR(s, n) ((s) + __builtin_bit_cast(float, __builtin_amdgcn_update_dpp(0, __builtin_bit_cast(int, (s)), 0x120 + (n), 0xf, 0xf, false)))
    v = WS_ROR(v, 8); v = WS_ROR(v, 4); v = WS_ROR(v, 2); v = WS_ROR(v, 1);
#undef WS_ROR
    { const unsigned sb = __builtin_bit_cast(unsigned, v); const auto p = __builtin_amdgcn_permlane16_swap(sb, sb, false, false); const unsigned p0 = p[0], p1 = p[1]; v = __builtin_bit_cast(float, p0) + __builtin_bit_cast(float, p1); }
    { const unsigned sb = __builtin_bit_cast(unsigned, v); const auto p = __builtin_amdgcn_permlane32_swap(sb, sb, false, false); const unsigned p0 = p[0], p1 = p[1]; v = __builtin_bit_cast(float, p0) + __builtin_bit_cast(float, p1); }
    return v;
}

__device__ __forceinline__ void p0_transpose_item(const float* W, int K, int N, bf16* WT, int k0, int n0, int drow0, LAS float* scr, int lane) {
#pragma unroll
    for (int i = 0; i < 32; ++i) { const int kk = 2 * i + (lane >> 5); scr[kk * 33 + (lane & 31)] = W[(size_t)(k0 + kk) * N + n0 + (lane & 31)]; }
    LDS_WAIT(); asm volatile("" ::: "memory");
    const int c = lane & 7;
#pragma unroll
    for (int j = 0; j < 4; ++j) { const int n = (lane >> 3) + 8 * j; const LAS float* s = scr + (8 * c) * 33 + n;
        v4u o; o.x = pk2(s[0 * 33], s[1 * 33]); o.y = pk2(s[2 * 33], s[3 * 33]); o.z = pk2(s[4 * 33], s[5 * 33]); o.w = pk2(s[6 * 33], s[7 * 33]);
        *(GAS v4u*)(WT + (size_t)(drow0 + n) * K + k0 + 8 * c) = o; }
    LDS_WAIT(); asm volatile("" ::: "memory");
}
__device__ __forceinline__ void p0_transpose_item8(const float* W, int K, int N, unsigned char* WT, int k0, int n0, int drow0, float scale, LAS float* scr, int lane) {
#pragma unroll
    for (int i = 0; i < 32; ++i) { const int kk = 2 * i + (lane >> 5); scr[kk * 33 + (lane & 31)] = W[(size_t)(k0 + kk) * N + n0 + (lane & 31)]; }
    LDS_WAIT(); asm volatile("" ::: "memory");
    const int n = lane >> 1, hf = lane & 1; const LAS float* sp = scr + (32 * hf) * 33 + n;
    unsigned w[8];
#pragma unroll
    for (int j = 0; j < 8; ++j) w[j] = pg8::cvt4_fp8(sp[(4 * j) * 33] * scale, sp[(4 * j + 1) * 33] * scale, sp[(4 * j + 2) * 33] * scale, sp[(4 * j + 3) * 33] * scale);
    GAS v4u* o = (GAS v4u*)(WT + (size_t)(drow0 + n) * K + k0 + 32 * hf);
    o[0] = (v4u){w[0], w[1], w[2], w[3]}; o[1] = (v4u){w[4], w[5], w[6], w[7]};
    LDS_WAIT(); asm volatile("" ::: "memory");
}
__device__ __forceinline__ void conv_stage(Frame& F, int stage, int wk, int nwk, int part = 0) {
    LAS float* scr = (LAS float*)(F.lds + RING_OFF + F.wave * 16384);
    constexpr int I_W1 = (D / 64) * (2 * DFF / 32), I_W2 = (DFF / 64) * (D / 32), I_HI = (D / 64) * (5 * D / 32), I_HO = (D / 64) * (D / 32), I_WP = (512 / 64) * (512 / 32);
    if (stage == 3) {
        for (int it = (part == 2 ? I_HI : 0) + wk; it < (part == 1 ? I_HI : I_HI + I_HO); it += nwk) {
            int r = it;
            if (r < I_HI) { const int nblk = 5 * D / 32, kb = r / nblk, nb = r % nblk;
                p0_transpose_item(F.in[12], D, 5 * D, (bf16*)(F.ws + WS_WHI), 64 * kb, 32 * nb, 32 * nb, scr, F.lane); continue; }
            r -= I_HI;
            { const int nblk = D / 32, kb = r / nblk, nb = r % nblk;
                p0_transpose_item(F.in[15], D, D, (bf16*)(F.ws + WS_WHO), 64 * kb, 32 * nb, 32 * nb, scr, F.lane); }
        }
        return;
    }
    const int mi = (stage == 0) ? 0 : (stage == 4 ? 3 : stage);
    const int nit = I_W1 + I_W2 + (stage == 0 ? 4 * I_WP : 0);
    for (int it = (part == 2 ? I_W1 : 0) + wk; it < (part == 1 ? I_W1 : nit); it += nwk) {
        int r = it;
        if (r < I_W1) { const int nblk = 2 * DFF / 32, kb = r / nblk, nb = r % nblk, n0 = 32 * nb;
            const int half = (n0 >= DFF) ? 1 : 0, j = n0 - half * DFF, drow0 = 256 * (j / 128) + 128 * half + (j % 128);
            if (F8_IN) p0_transpose_item8(F.in[8] + (size_t)mi * D * 2 * DFF, D, 2 * DFF, (unsigned char*)(F.ws + WS_W1T) + (size_t)mi * W1T_STRIDE * 2, 64 * kb, n0, drow0, 64.0f, scr, F.lane);
            else p0_transpose_item(F.in[8] + (size_t)mi * D * 2 * DFF, D, 2 * DFF, (bf16*)(F.ws + WS_W1T) + (size_t)mi * W1T_STRIDE, 64 * kb, n0, drow0, scr, F.lane);
            continue; }
        r -= I_W1;
        if (r < I_W2) { const int nblk = D / 32, kb = r / nblk, nb = r % nblk;
            if (F8_OUT) p0_transpose_item8(F.in[9] + (size_t)mi * DFF * D, DFF, D, (unsigned char*)(F.ws + WS_W2T) + (size_t)mi * W2T_STRIDE * 2, 64 * kb, 32 * nb, 32 * nb, 128.0f, scr, F.lane);
            else p0_transpose_item(F.in[9] + (size_t)mi * DFF * D, DFF, D, (bf16*)(F.ws + WS_W2T) + (size_t)mi * W2T_STRIDE, 64 * kb, 32 * nb, 32 * nb, scr, F.lane);
            continue; }
        r -= I_W2;
        { const int gi = r / I_WP; r -= gi * I_WP; const int nblk = 512 / 32, kb = r / nblk, nb = r % nblk;
            p0_transpose_item(F.in[10] + (size_t)gi * 512 * 512, 512, 512, (bf16*)(F.ws + WS_WPT) + (size_t)gi * 512 * 512, 64 * kb, 32 * nb, 32 * nb, scr, F.lane); }
    }
}
__device__ __forceinline__ void mod_gemv(Frame& F, const LAS float* sv, int layer0, int lo, int hi, int wk, int nwk) {
    float* mod = (float*)(F.ws + WS_MOD);
    const int total = hi - lo, per = (total + nwk - 1) / nwk;
    int idx = lo + wk * per; const int iend = (idx + per) < hi ? (idx + per) : hi;
    while (idx < iend) {
        const int strip_g = idx / D, k0 = idx % D, layer = layer0 + strip_g / 72, strip = strip_g % 72;
        const int kend = (k0 + (iend - idx)) < D ? (k0 + (iend - idx)) : D;
        const float* W = F.in[4] + (size_t)layer * D * NMOD + strip * 256 + 4 * F.lane;
        f32x4 al = {0.f, 0.f, 0.f, 0.f}, ac = {0.f, 0.f, 0.f, 0.f};
#pragma unroll 8
        for (int k = k0; k < kend; ++k) { const f32x4 w = *(const GAS f32x4*)(W + (size_t)k * NMOD); const float s0 = sv[k], s1 = sv[D + k]; al += w * s0; ac += w * s1; }
        const int col = strip * 256 + 4 * F.lane;
        if (k0 == 0) { const f32x4 b = *(const f32x4*)(F.in[5] + (size_t)layer * NMOD + col); al += b; ac += b; }
        float* ml = mod + (size_t)(layer * 2 + 0) * NMOD + col; float* mc = mod + (size_t)(layer * 2 + 1) * NMOD + col;
#pragma unroll
        for (int j = 0; j < 4; ++j) { atomicAdd(ml + j, al[j]); atomicAdd(mc + j, ac[j]); }
        idx += kend - k0;
    }
}
__device__ __forceinline__ void p0_prologue(Frame& F, const bool do_mod) {
    LAS float* scr = (LAS float*)(F.lds + RING_OFF + F.wave * 16384);
    LAS float* sv = (LAS float*)(F.lds + SVEC_OFF);
    for (int i = F.tid; i < 2 * D; i += NTHREADS) { const float x = (i < D) ? F.in[1][i] : F.in[3][i - D]; sv[i] = pg8::fsilu(x); }
    if (blockIdx.x == 0) { float* vec = (float*)(F.ws + WS_VEC); for (int i = F.tid; i < 2 * D; i += NTHREADS) vec[i] = (i < D) ? 1.0f : 0.0f; }
    __syncthreads();
    const int gw = F.gw, NGW = F.NGW;
    if (do_mod) mod_gemv(F, sv, 0, 0, 72 * D, gw, NGW);
    conv_stage(F, 0, gw, NGW, 1);
}

struct CtxComb { const float* slab; const void* zprev; const float* lgp; const float* lbp; const float* gate; _Float16* zout; };
typedef _Float16 hf16x4 __attribute__((ext_vector_type(4)));
__device__ __forceinline__ f32x4 h4_to_f4(hf16x4 h) { return (f32x4){(float)h[0], (float)h[1], (float)h[2], (float)h[3]}; }
__device__ __forceinline__ hf16x4 f4_to_h4(f32x4 v) { return (hf16x4){(_Float16)v.x, (_Float16)v.y, (_Float16)v.z, (_Float16)v.w}; }
template <int MODE, bool COMB = false, bool F8 = false, bool ZPREV_F32 = false>
__device__ __forceinline__ void t_rows(Frame& F, const void* z_lat, const void* z_ctx, const float* lg, const float* lb, const float* mod_lat, const float* mod_ctx, int sub,
                                       bf16* H, float* outf, float* RS, int nrows, const CtxComb cc = CtxComb{}) {
    const int gw = F.gw, NGW = F.NGW, lane = F.lane;
    {
        const int rhi = nrows < SEQ ? nrows : SEQ;
        int r = gw;
        if (r < rhi) {
            f32x4 P[8], Q[8];
#pragma unroll
            for (int j = 0; j < 8; ++j) { const int c = 4 * lane + 256 * j;
                f32x4 g = {1.f, 1.f, 1.f, 1.f}, b = {0.f, 0.f, 0.f, 0.f};
                if (MODE != 0) { g = *(const f32x4*)(lg + c); b = *(const f32x4*)(lb + c); }
                if (MODE != 2) { const f32x4 sh = *(const f32x4*)(mod_lat + (size_t)(sub * 3 + 0) * D + c), sc = *(const f32x4*)(mod_lat + (size_t)(sub * 3 + 1) * D + c); P[j] = g * (sc + 1.0f); Q[j] = b * (sc + 1.0f) + sh; }
                else { P[j] = g; Q[j] = b; } }
            f32x4 rawf[MODE == 0 ? 8 : 1]; hf16x4 rawh[MODE == 0 ? 1 : 8];
#define TR_LOAD(row_) do { const size_t zo_ = (size_t)(row_) * D; _Pragma("unroll") for (int j = 0; j < 8; ++j) { \
            if constexpr (MODE == 0) rawf[j] = ((const GAS f32x4*)((const float*)z_lat + zo_) + lane)[64 * j]; else rawh[j] = ((const GAS hf16x4*)((const _Float16*)z_lat + zo_) + lane)[64 * j]; } } while (0)
            TR_LOAD(r);
#pragma unroll 1
            for (; r < rhi; r += NGW) {
                f32x4 v[8]; float s = 0.f;
#pragma unroll
                for (int j = 0; j < 8; ++j) { if constexpr (MODE == 0) v[j] = rawf[j]; else v[j] = h4_to_f4(rawh[j]);
                    s += (v[j].x + v[j].y) + (v[j].z + v[j].w); }
                asm volatile("" ::: "memory");
                if (r + NGW < rhi) TR_LOAD(r + NGW);
                asm volatile("" ::: "memory");
                float mean = 0.f, rstd = 1.f;
                if (MODE != 0) {
                    mean = wave_sum(s) * (1.f / D); float s2 = 0.f;
#pragma unroll
                    for (int j = 0; j < 8; ++j) { const f32x4 d = v[j] - mean; s2 += (d.x * d.x + d.y * d.y) + (d.z * d.z + d.w * d.w); }
                    rstd = 1.0f / sqrtf(wave_sum(s2) * (1.f / D) + LN_EPS);
                }
                if (MODE != 2 && lane == 0) *(f32x2*)(RS + 2 * (size_t)r) = (f32x2){mean, rstd};
                if (MODE == 2) { GAS f32x4* o = (GAS f32x4*)(outf + (size_t)r * D) + lane;
#pragma unroll
                    for (int j = 0; j < 8; ++j) o[64 * j] = ((v[j] - mean) * rstd) * P[j] + Q[j];
                } else if (F8) { GAS unsigned* o = (GAS unsigned*)((unsigned char*)H + (size_t)r * D) + lane;
#pragma unroll
                    for (int j = 0; j < 8; ++j) { const f32x4 h = ((v[j] - mean) * rstd) * P[j] + Q[j]; o[64 * j] = pg8::cvt4_fp8(h.x, h.y, h.z, h.w); }
                } else { GAS v2u* o = (GAS v2u*)(H + (size_t)r * D) + lane;
#pragma unroll
                    for (int j = 0; j < 8; ++j) { const f32x4 h = ((v[j] - mean) * rstd) * P[j] + Q[j]; v2u w; w.x = pk2(h.x, h.y); w.y = pk2(h.z, h.w); o[64 * j] = w; } }
            }
#undef TR_LOAD
        }
    }
    if (MODE != 2 && nrows > SEQ) {
        LAS float* red = (LAS float*)(F.lds + SVEC_OFF);
        const int c = 256 * F.wave + 4 * lane;
        f32x4 g = {1.f, 1.f, 1.f, 1.f}, b = {0.f, 0.f, 0.f, 0.f};
        if (MODE != 0) { g = *(const f32x4*)(lg + c); b = *(const f32x4*)(lb + c); }
        const f32x4 sh = *(const f32x4*)(mod_ctx + (size_t)(sub * 3 + 0) * D + c), sc = *(const f32x4*)(mod_ctx + (size_t)(sub * 3 + 1) * D + c);
        const f32x4 Pc = g * (sc + 1.0f), Qc = b * (sc + 1.0f) + sh;
#pragma unroll 1
        for (int j = (int)blockIdx.x; j < nrows - SEQ; j += F.G) { const int r = SEQ + j; const size_t ro = (size_t)j * D;
            f32x4 v;
            if (COMB) {
                const f32x2 st0 = *(const f32x2*)(RS + 2 * (size_t)r); f32x4 a = {0.f, 0.f, 0.f, 0.f};
#pragma unroll
                for (int sp = 0; sp < NSPLIT; ++sp) a += *(const GAS f32x4*)(cc.slab + (size_t)sp * CTXL * D + ro + c);
                const f32x4 zp = ZPREV_F32 ? *(const GAS f32x4*)((const float*)cc.zprev + ro + c) : h4_to_f4(*(const GAS hf16x4*)((const _Float16*)cc.zprev + ro + c));
                const f32x4 xp = ((zp - st0.x) * st0.y) * *(const f32x4*)(cc.lgp + c) + *(const f32x4*)(cc.lbp + c);
                const hf16x4 zh = f4_to_h4(xp * ALPHA + (*(const f32x4*)(cc.gate + c) * COMB_SCALE) * a);
                *(GAS hf16x4*)(cc.zout + ro + c) = zh; v = h4_to_f4(zh);
            } else {
                if constexpr (MODE == 0) v = *(const GAS f32x4*)((const float*)z_ctx + ro + c); else v = h4_to_f4(*(const GAS hf16x4*)((const _Float16*)z_ctx + ro + c));
            }
            float mean = 0.f, rstd = 1.f;
            if (MODE != 0) {
                const float s = wave_sum((v.x + v.y) + (v.z + v.w));
                if (lane == 0) red[F.wave] = s;
                __syncthreads();
                { const f32x4 r0 = *(const LAS f32x4*)(red), r1 = *(const LAS f32x4*)(red + 4); mean = (((r0.x + r0.y) + (r0.z + r0.w)) + ((r1.x + r1.y) + (r1.z + r1.w))) * (1.f / D); }
                const f32x4 d = v - mean;
                const float s2 = wave_sum((d.x * d.x + d.y * d.y) + (d.z * d.z + d.w * d.w));
                if (lane == 0) red[8 + F.wave] = s2;
                __syncthreads();
                { const f32x4 r0 = *(const LAS f32x4*)(red + 8), r1 = *(const LAS f32x4*)(red + 12); rstd = 1.0f / sqrtf((((r0.x + r0.y) + (r0.z + r0.w)) + ((r1.x + r1.y) + (r1.z + r1.w))) * (1.f / D) + LN_EPS); }
                __syncthreads();
            }
            if (F.tid == 0) *(f32x2*)(RS + 2 * (size_t)r) = (f32x2){mean, rstd};
            const f32x4 h = ((v - mean) * rstd) * Pc + Qc;
            if (F8) *(GAS unsigned*)((unsigned char*)H + (size_t)r * D + c) = pg8::cvt4_fp8(h.x, h.y, h.z, h.w);
            else { v2u w; w.x = pk2(h.x, h.y); w.y = pk2(h.z, h.w); *(GAS v2u*)(H + (size_t)r * D + c) = w; }
        }
    }
}

__device__ __forceinline__ void unpack8(const v4u w, float (&f)[8]) {
    f[0] = __builtin_bit_cast(float, w.x << 16); f[1] = __builtin_bit_cast(float, w.x & 0xffff0000u); f[2] = __builtin_bit_cast(float, w.y << 16); f[3] = __builtin_bit_cast(float, w.y & 0xffff0000u);
    f[4] = __builtin_bit_cast(float, w.z << 16); f[5] = __builtin_bit_cast(float, w.z & 0xffff0000u); f[6] = __builtin_bit_cast(float, w.w << 16); f[7] = __builtin_bit_cast(float, w.w & 0xffff0000u);
}
template <int HW, int NR>
__device__ __forceinline__ void tp_pool_band(Frame& F, const bf16* H, bf16* PB, int band, int slab) {
    constexpr int VMP = 72, W2 = 2 * HW;
    LAS float* VM = (LAS float*)(F.lds + RING_OFF);
    const int tid = F.tid, c = tid >> 3, oct = tid & 7, R0 = band * NR, ch = slab * 64 + oct * 8;
    const bf16* base = H + (size_t)c * D + ch;
    v4u ring[W2]; float rs[8];
#pragma unroll
    for (int j = 0; j < 8; ++j) rs[j] = 0.f;
#pragma unroll
    for (int k = 0; k < W2; ++k) { const int row = R0 - HW + k; v4u v = {0u, 0u, 0u, 0u}; if (row >= 0 && row < 256) v = *(const GAS v4u*)(base + (size_t)row * 64 * D); ring[(k + HW) % W2] = v; }
    v4u pn = {0u, 0u, 0u, 0u};
    if (R0 + HW < 256) pn = *(const GAS v4u*)(base + (size_t)(R0 + HW) * 64 * D);
#pragma unroll
    for (int k = 0; k < W2; ++k) { float f[8]; unpack8(ring[k], f);
#pragma unroll
        for (int j = 0; j < 8; ++j) rs[j] += f[j]; }
    const int clo = (c - HW) < 0 ? 0 : (c - HW), chi = (c + HW) > 64 ? 64 : (c + HW); const float icc = 1.0f / (float)(chi - clo);
#pragma unroll 1
    for (int ob = 0; ob < NR; ob += W2) {
#pragma unroll
        for (int k = 0; k < W2; ++k) { const int i = ob + k, R = R0 + i; constexpr int dummy_ = 0; (void)dummy_;
            const int es = (k + HW - 1) % W2;
            if (i > 0) { float fn[8], fo[8]; unpack8(pn, fn); unpack8(ring[es], fo);
#pragma unroll
                for (int j = 0; j < 8; ++j) { rs[j] += fn[j]; rs[j] -= fo[j]; }
                ring[es] = pn; }
            asm volatile("" ::: "memory");
            { v4u nx = {0u, 0u, 0u, 0u}; if (i + 1 < NR && R + HW < 256) nx = *(const GAS v4u*)(base + (size_t)(R + HW) * 64 * D); pn = nx; }
            asm volatile("" ::: "memory");
            const int lo = (R - HW) < 0 ? 0 : (R - HW), hi = (R + HW) > 256 ? 256 : (R + HW); const float icr = 1.0f / (float)(hi - lo);
            LAS float* vm = VM + (i & 1) * 64 * VMP;
            *(LAS f32x4*)(vm + c * VMP + oct * 8) = (f32x4){rs[0] * icr, rs[1] * icr, rs[2] * icr, rs[3] * icr};
            *(LAS f32x4*)(vm + c * VMP + oct * 8 + 4) = (f32x4){rs[4] * icr, rs[5] * icr, rs[6] * icr, rs[7] * icr};
            float hc[8]; unpack8(ring[k], hc);
            __syncthreads();
            f32x4 a0 = {0.f, 0.f, 0.f, 0.f}, a1 = {0.f, 0.f, 0.f, 0.f};
            for (int cc = clo; cc < chi; ++cc) { a0 += *(const LAS f32x4*)(vm + cc * VMP + oct * 8); a1 += *(const LAS f32x4*)(vm + cc * VMP + oct * 8 + 4); }
            v4u o; o.x = pk2(a0.x * icc - hc[0], a0.y * icc - hc[1]); o.y = pk2(a0.z * icc - hc[2], a0.w * icc - hc[3]);
            o.z = pk2(a1.x * icc - hc[4], a1.y * icc - hc[5]); o.w = pk2(a1.z * icc - hc[6], a1.w * icc - hc[7]);
            *(GAS v4u*)(PB + (size_t)(R * 64 + c) * D + ch) = o;
        }
    }
    __syncthreads();
}
__device__ __forceinline__ void tp_pool(Frame& F, const bf16* H, bf16* PB) {
    const int tid = F.tid;
#pragma unroll 1
    for (int tile = blockIdx.x; tile < 256; tile += F.G) {
        if (tile < 128) tp_pool_band<8, 16>(F, H, PB, tile >> 3, 24 + (tile & 7));
        else if (tile < 192) tp_pool_band<4, 32>(F, H, PB, (tile - 128) >> 3, 16 + (tile & 7));
        else if (tile < 224) tp_pool_band<2, 64>(F, H, PB, (tile - 192) >> 3, 8 + (tile & 7));
        else tp_pool_band<1, 64>(F, H, PB, (tile - 224) >> 3, tile & 7);
    }
    for (int item = blockIdx.x * NTHREADS + tid; item < CTXL * 256; item += F.G * NTHREADS) {
        const int t = item >> 8, o8 = item & 255, ch = o8 * 8, grp = ch >> 9, w = 2 << grp, hw = w >> 1;
        const int lo = (t - hw) < 0 ? 0 : (t - hw), hi = (t + hw) > CTXL ? CTXL : (t + hw);
        float a[8];
#pragma unroll
        for (int j = 0; j < 8; ++j) a[j] = 0.f;
        v4u wr[16];
#pragma unroll
        for (int q = 0; q < 16; ++q) { v4u x = {0u, 0u, 0u, 0u}; if (lo + q < hi) x = *(const GAS v4u*)(H + (size_t)(SEQ + lo + q) * D + ch); wr[q] = x; }
#pragma unroll
        for (int q = 0; q < 16; ++q) { float f[8]; unpack8(wr[q], f);
#pragma unroll
            for (int j = 0; j < 8; ++j) a[j] += f[j]; }
        float hc[8]; unpack8(*(const GAS v4u*)(H + (size_t)(SEQ + t) * D + ch), hc); const float ic = 1.0f / (float)(hi - lo);
        v4u o; o.x = pk2(a[0] * ic - hc[0], a[1] * ic - hc[1]); o.y = pk2(a[2] * ic - hc[2], a[3] * ic - hc[3]); o.z = pk2(a[4] * ic - hc[4], a[5] * ic - hc[5]); o.w = pk2(a[6] * ic - hc[6], a[7] * ic - hc[7]);
        *(GAS v4u*)(PB + (size_t)(SEQ + t) * D + ch) = o;
    }
}

#define MK_RSRC(p, bytes) __builtin_amdgcn_make_buffer_rsrc((void*)(p), 0, (int)(bytes), 0x00020000)
#define BLD32(rs, vo, so) ((unsigned)__builtin_amdgcn_raw_buffer_load_b32((rs), (int)(vo), (int)(so), 0))
#define BLD16(rs, vo, so) ((unsigned short)__builtin_amdgcn_raw_buffer_load_b16((rs), (int)(vo), (int)(so), 0))
#define BST32(rs, x, vo, so) __builtin_amdgcn_raw_buffer_store_b32((unsigned)(x), (rs), (int)(vo), (int)(so), 0)
#define BST16(rs, x, vo, so) __builtin_amdgcn_raw_buffer_store_b16((unsigned short)(x), (rs), (int)(vo), (int)(so), 0)
#define BLD64(rs, vo, so) (__builtin_amdgcn_raw_buffer_load_b64((rs), (int)(vo), (int)(so), 0))
#define BST64(rs, x, vo, so) __builtin_amdgcn_raw_buffer_store_b64((x), (rs), (int)(vo), (int)(so), 0)
constexpr int SC_QT = 0, SC_KT = 17408, SC_KTT = 34816, SC_VT = 53248, SC_AT = 71680, SC_QTOT = 80896, SC_FAC = 84992, SC_SSQ = 85504, SC_END = 87552;
struct ScanT { const bf16* Q; const bf16* V; const unsigned short* G0; const unsigned short* G1; const bf16* OG; float* OF; bf16* YG; float* ST; float* CST; float* DT; const float* normg; };

template <bool PHC>
__device__ __forceinline__ void scan_unit(Frame& F, const ScanT& T, int h, int dir, int tfirst, int cstride, int nch, const float* st_in, float* st_out, float* dt_out) {
    LAS unsigned char* L = F.lds + RING_OFF;
    const int lane = F.lane, w = F.wave, l15 = lane & 15, h4 = lane >> 4;
    const int cp = lane, tg = w;
    constexpr unsigned A2B = (unsigned)MALL * D * 2u, A4B = (unsigned)SEQ * D * 4u;
    const __amdgpu_buffer_rsrc_t rsG = MK_RSRC(dir ? T.G1 : T.G0, A2B), rsV = MK_RSRC(T.V, A2B), rsQ = MK_RSRC(T.Q, A2B), rsOG = MK_RSRC(T.OG, A2B), rsYG = MK_RSRC(T.YG, A2B), rsOF = MK_RSRC(T.OF, A2B);
    const unsigned coffb = (unsigned)(h * HK + 2 * cp) * 2u;
    f32x4 R[8];
    if (PHC) {
#pragma unroll
        for (int t = 0; t < 8; ++t)
#pragma unroll
            for (int r = 0; r < 4; ++r) R[t][r] = st_in[w * 2048 + (t * 4 + r) * 64 + lane];
    } else {
#pragma unroll
        for (int t = 0; t < 8; ++t) R[t] = (f32x4){0.f, 0.f, 0.f, 0.f};
    }
    float cprev0 = 1.f, cprev1 = 1.f;
    unsigned gr[8], qr[8], vr[8];
#define SC_LOAD(cidx) do { const int _b = tfirst + (cidx) * cstride; _Pragma("unroll") for (int i = 0; i < 8; ++i) { const int tau = 8 * tg + i; const int tok = dir ? (_b + 63 - tau) : (_b + tau); \
        const unsigned so = (unsigned)tok * 4096u; gr[i] = BLD32(rsG, coffb, so); vr[i] = BLD32(rsV, coffb, so); if (PHC) qr[i] = BLD32(rsQ, coffb, so); } } while (0)
#define SC_H2F(x) ((float)__builtin_bit_cast(_Float16, (unsigned short)(x)))
#define SC_BAR() do { asm volatile("s_waitcnt lgkmcnt(0)" ::: "memory"); __builtin_amdgcn_s_barrier(); asm volatile("" ::: "memory"); } while (0)
#define SC_CLAMP(x, lim) ((x) > (lim) ? (lim) : ((x) < -(lim) ? -(lim) : (x)))
#define SC_MFMA(a, b, c) __builtin_amdgcn_mfma_f32_16x16x32_bf16((a), (b), (c), 0, 0, 0)
#define SC_ROR_ADD(s, n) ((s) + __builtin_bit_cast(float, __builtin_amdgcn_update_dpp(0, __builtin_bit_cast(int, (s)), 0x120 + (n), 0xf, 0xf, false)))
    SC_LOAD(0);
#pragma unroll 1
    for (int c = 0; c < nch; ++c) {
        const int tbase = tfirst + c * cstride;
        float f0[8], f1[8], kq0[8], kq1[8]; float run0 = 1.f, run1 = 1.f;
#pragma unroll
        for (int i = 0; i < 8; ++i) { kq0[i] = SC_H2F(gr[i] & 0xffffu); kq1[i] = SC_H2F(gr[i] >> 16); f0[i] = 1.0f - kq0[i]; f1[i] = 1.0f - kq1[i]; run0 *= f0[i]; run1 *= f1[i]; }
        *(LAS f32x2*)(L + SC_QTOT + (tg * 128 + 2 * cp) * 4) = (f32x2){run0, run1};
        SC_BAR();
        float num0 = 1.f, num1 = 1.f, den0 = 1.f, den1 = 1.f, lo0 = 1.f, lo1 = 1.f, hi0 = 1.f, hi1 = 1.f;
#pragma unroll
        for (int g = 0; g < 8; ++g) { const f32x2 t = *(const LAS f32x2*)(L + SC_QTOT + (g * 128 + 2 * cp) * 4);
            if (g < 4) { lo0 *= t.x; lo1 *= t.y; if (g >= tg) { den0 *= t.x; den1 *= t.y; } } else { hi0 *= t.x; hi1 *= t.y; if (g < tg) { num0 *= t.x; num1 *= t.y; } } }
        float e0 = num0 * __builtin_amdgcn_rcpf(fmaxf(den0, 1e-30f)), e1 = num1 * __builtin_amdgcn_rcpf(fmaxf(den1, 1e-30f));
        unsigned kc0[4], kc1[4], vc0[4], vc1[4]; float kp0 = 0.f, kp1 = 0.f;
#pragma unroll
        for (int i = 0; i < 8; ++i) {
            const int tau = 8 * tg + i;
            e0 *= f0[i]; e1 *= f1[i];
            const float k0 = kq0[i] * __builtin_amdgcn_rcpf(fmaxf(e0, 1e-30f)), k1 = kq1[i] * __builtin_amdgcn_rcpf(fmaxf(e1, 1e-30f));
            *(LAS unsigned*)(L + SC_KT + tau * 272 + cp * 4) = pg8::cvt_pk_bf16(k0, k1);
            if (PHC) { const float q0 = __builtin_bit_cast(float, qr[i] << 16) * e0, q1 = __builtin_bit_cast(float, qr[i] & 0xffff0000u) * e1;
                *(LAS unsigned*)(L + SC_QT + tau * 272 + cp * 4) = pg8::cvt_pk_bf16(q0, q1); }
            if (i & 1) { kc0[i >> 1] = pg8::cvt_pk_bf16(kp0, k0); kc1[i >> 1] = pg8::cvt_pk_bf16(kp1, k1);
                vc0[i >> 1] = __builtin_amdgcn_perm(vr[i], vr[i - 1], 0x05040100u); vc1[i >> 1] = __builtin_amdgcn_perm(vr[i], vr[i - 1], 0x07060302u); }
            else { kp0 = k0; kp1 = k1; }
        }
        *(LAS v4u*)(L + SC_KTT + (2 * cp) * 144 + tg * 16) = (v4u){kc0[0], kc0[1], kc0[2], kc0[3]}; *(LAS v4u*)(L + SC_KTT + (2 * cp + 1) * 144 + tg * 16) = (v4u){kc1[0], kc1[1], kc1[2], kc1[3]};
        *(LAS v4u*)(L + SC_VT + (2 * cp) * 144 + tg * 16) = (v4u){vc0[0], vc0[1], vc0[2], vc0[3]}; *(LAS v4u*)(L + SC_VT + (2 * cp + 1) * 144 + tg * 16) = (v4u){vc1[0], vc1[1], vc1[2], vc1[3]};
        if (tg == 0) { *(LAS f32x2*)(L + SC_FAC + (2 * cp) * 4) = (f32x2){lo0 * cprev0, lo1 * cprev1}; cprev0 = hi0; cprev1 = hi1; }
        if (c + 1 < nch) SC_LOAD(c + 1);
        SC_BAR();
        const unsigned ocolb = (unsigned)(h * HK + 16 * w + 4 * h4) * 2u, orowb = (unsigned)(dir ? (15 - l15) : l15) * 4096u;
        v2u ofv[4]; v2u ogv[4];
        if (PHC && dir) {
#pragma unroll
            for (int tt = 0; tt < 4; ++tt) ofv[tt] = BLD64(rsOF, orowb + ocolb, (unsigned)(tbase + 48 - 16 * tt) * 4096u);
        }
#pragma unroll
        for (int t = 0; t < 8; ++t) { const f32x4 f = *(const LAS f32x4*)(L + SC_FAC + (16 * t + 4 * h4) * 4); R[t] = R[t] * f; }
        if (PHC) {
            const int tt = w >> 1, st0 = 2 * (w & 1);
            bf16x8 qb[4], ka[2][4];
#pragma unroll
            for (int ks = 0; ks < 4; ++ks) { qb[ks] = *(const LAS bf16x8*)(L + SC_QT + (16 * tt + l15) * 272 + (32 * ks + 8 * h4) * 2);
#pragma unroll
                for (int q = 0; q < 2; ++q) ka[q][ks] = *(const LAS bf16x8*)(L + SC_KT + (16 * (st0 + q) + l15) * 272 + (32 * ks + 8 * h4) * 2); }
#pragma unroll
            for (int q = 0; q < 2; ++q) { const int st = st0 + q; f32x4 a = {0.f, 0.f, 0.f, 0.f};
                if (st <= tt) {
#pragma unroll
                    for (int ks = 0; ks < 4; ++ks) a = SC_MFMA(ka[q][ks], qb[ks], a);
                    if (st == tt) {
#pragma unroll
                        for (int r = 0; r < 4; ++r) if (4 * h4 + r > l15) a[r] = 0.f; }
                }
                v2u o; o.x = pg8::cvt_pk_bf16(a[0], a[1]); o.y = pg8::cvt_pk_bf16(a[2], a[3]);
                *(LAS v2u*)(L + SC_AT + (16 * tt + l15) * 144 + (16 * st + 4 * h4) * 2) = o; }
            SC_BAR();
        }
        bf16x8 vb[2];
#pragma unroll
        for (int ss = 0; ss < 2; ++ss) vb[ss] = *(const LAS bf16x8*)(L + SC_VT + (16 * w + l15) * 144 + (32 * ss + 8 * h4) * 2);
        f32x4 O[4];
        if (PHC) {
            bf16x8 rb[4];
#pragma unroll
            for (int ks = 0; ks < 4; ++ks) { v4u p; p.x = pg8::cvt_pk_bf16(R[2 * ks][0], R[2 * ks][1]); p.y = pg8::cvt_pk_bf16(R[2 * ks][2], R[2 * ks][3]); p.z = pg8::cvt_pk_bf16(R[2 * ks + 1][0], R[2 * ks + 1][1]); p.w = pg8::cvt_pk_bf16(R[2 * ks + 1][2], R[2 * ks + 1][3]); rb[ks] = __builtin_bit_cast(bf16x8, p); }
#pragma unroll
            for (int hf = 0; hf < 2; ++hf) {
                v2u qa[2][4][2]; bf16x8 aa[2][2];
#pragma unroll
                for (int t2 = 0; t2 < 2; ++t2) { const int tt = 2 * hf + t2;
#pragma unroll
                    for (int ks = 0; ks < 4; ++ks) { qa[t2][ks][0] = *(const LAS v2u*)(L + SC_QT + (16 * tt + l15) * 272 + (32 * ks + 4 * h4) * 2); qa[t2][ks][1] = *(const LAS v2u*)(L + SC_QT + (16 * tt + l15) * 272 + (32 * ks + 16 + 4 * h4) * 2); }
#pragma unroll
                    for (int ss = 0; ss <= hf; ++ss) aa[t2][ss] = *(const LAS bf16x8*)(L + SC_AT + (16 * tt + l15) * 144 + (32 * ss + 8 * h4) * 2); }
                __builtin_amdgcn_sched_barrier(0);
#pragma unroll
                for (int t2 = 0; t2 < 2; ++t2) { f32x4 o = {0.f, 0.f, 0.f, 0.f};
#pragma unroll
                    for (int ks = 0; ks < 4; ++ks) { const v4u av = {qa[t2][ks][0].x, qa[t2][ks][0].y, qa[t2][ks][1].x, qa[t2][ks][1].y}; o = SC_MFMA(rb[ks], __builtin_bit_cast(bf16x8, av), o); }
#pragma unroll
                    for (int ss = 0; ss <= hf; ++ss) o = SC_MFMA(vb[ss], aa[t2][ss], o);
                    O[2 * hf + t2] = o; }
            }
        }
#pragma unroll
        for (int gq = 0; gq < 2; ++gq) {
            bf16x8 kk[4][2];
#pragma unroll
            for (int t = 0; t < 4; ++t)
#pragma unroll
                for (int ss = 0; ss < 2; ++ss) kk[t][ss] = *(const LAS bf16x8*)(L + SC_KTT + (16 * (4 * gq + t) + l15) * 144 + (32 * ss + 8 * h4) * 2);
            __builtin_amdgcn_sched_barrier(0);
#pragma unroll
            for (int t = 0; t < 4; ++t)
#pragma unroll
                for (int ss = 0; ss < 2; ++ss) R[4 * gq + t] = SC_MFMA(kk[t][ss], vb[ss], R[4 * gq + t]);
        }
        if (PHC) {
            typedef _Float16 h2_t __attribute__((ext_vector_type(2)));
            if (dir == 0) {
#pragma unroll
                for (int tt = 0; tt < 4; ++tt) { const h2_t a = {(_Float16)O[tt][0], (_Float16)O[tt][1]}, b = {(_Float16)O[tt][2], (_Float16)O[tt][3]};
                    const unsigned wa = __builtin_bit_cast(unsigned, a), wb = __builtin_bit_cast(unsigned, b); const v2u wv = {wa, wb};
                    BST64(rsOF, wv, orowb + ocolb, (unsigned)(tbase + 16 * tt) * 4096u); }
            } else {
#pragma unroll
                for (int tt = 0; tt < 4; ++tt) ogv[tt] = BLD64(rsOG, orowb + ocolb, (unsigned)(tbase + 48 - 16 * tt) * 4096u);
                float tot[16];
#pragma unroll
                for (int tt = 0; tt < 4; ++tt) {
                    const unsigned ofx = ofv[tt].x, ofy = ofv[tt].y; const h2_t f01 = __builtin_bit_cast(h2_t, ofx), f23 = __builtin_bit_cast(h2_t, ofy);
                    const float x0 = O[tt][0] + (float)f01[0], x1 = O[tt][1] + (float)f01[1], x2 = O[tt][2] + (float)f23[0], x3 = O[tt][3] + (float)f23[1];
                    tot[tt * 4 + 0] = x0; tot[tt * 4 + 1] = x1; tot[tt * 4 + 2] = x2; tot[tt * 4 + 3] = x3;
                    float sq = (x0 * x0 + x1 * x1) + (x2 * x2 + x3 * x3);
                    { const unsigned sb = __builtin_bit_cast(unsigned, sq); const auto p = __builtin_amdgcn_permlane16_swap(sb, sb, false, false); const unsigned p0 = p[0], p1 = p[1]; sq = __builtin_bit_cast(float, p0) + __builtin_bit_cast(float, p1); }
                    { const unsigned sb = __builtin_bit_cast(unsigned, sq); const auto p = __builtin_amdgcn_permlane32_swap(sb, sb, false, false); const unsigned p0 = p[0], p1 = p[1]; sq = __builtin_bit_cast(float, p0) + __builtin_bit_cast(float, p1); }
                    if (h4 == 0) ((LAS float*)(L + SC_SSQ))[(16 * tt + l15) * 8 + w] = sq; }
                SC_BAR();
                const f32x4 ng = *(const f32x4*)(T.normg + 16 * w + 4 * h4);
#pragma unroll
                for (int tt = 0; tt < 4; ++tt) { const int tau = 16 * tt + l15;
                    const f32x4 s0 = *(const LAS f32x4*)(L + SC_SSQ + tau * 32), s1 = *(const LAS f32x4*)(L + SC_SSQ + tau * 32 + 16);
                    const float ss = ((s0.x + s0.y) + (s0.z + s0.w)) + ((s1.x + s1.y) + (s1.z + s1.w));
                    const float rstd = __builtin_amdgcn_rsqf(ss * (1.0f / 128.0f) + RMS_EPS);
                    const unsigned ogx = ogv[tt].x, ogy = ogv[tt].y; const unsigned gb0 = ogx << 16, gb1 = ogx & 0xffff0000u, gb2 = ogy << 16, gb3 = ogy & 0xffff0000u;
                    const float g0 = __builtin_bit_cast(float, gb0), g1 = __builtin_bit_cast(float, gb1), g2 = __builtin_bit_cast(float, gb2), g3 = __builtin_bit_cast(float, gb3);
                    const v2u wv = {pg8::cvt_pk_bf16(tot[tt * 4 + 0] * rstd * ng[0] * g0, tot[tt * 4 + 1] * rstd * ng[1] * g1), pg8::cvt_pk_bf16(tot[tt * 4 + 2] * rstd * ng[2] * g2, tot[tt * 4 + 3] * rstd * ng[3] * g3)};
                    BST64(rsYG, wv, orowb + ocolb, (unsigned)(tbase + 48 - 16 * tt) * 4096u); }
            }
        }
    }
    static_assert(PHC, "the state-only pass is scan_state_unit");
    SC_BAR();
#undef SC_LOAD
#undef SC_H2F
#undef SC_CLAMP
#undef SC_BAR
#undef SC_MFMA
#undef SC_ROR_ADD
}

__device__ __forceinline__ void scan_state_unit(Frame& F, const ScanT& T, int h, int dir, int tfirst, int cstride, int nch, float* st_out, float* dt_out) {
    LAS unsigned char* L = F.lds + RING_OFF;
    const int lane = F.lane, w = F.wave, l15 = lane & 15, h4 = lane >> 4;
    const int cp = lane, tg = w;
    constexpr unsigned A2B = (unsigned)MALL * D * 2u;
    const __amdgpu_buffer_rsrc_t rsG = MK_RSRC(dir ? T.G1 : T.G0, A2B), rsV = MK_RSRC(T.V, A2B);
    const unsigned coffb = (unsigned)(h * HK + 2 * cp) * 2u;
    f32x4 R[8];
#pragma unroll
    for (int t = 0; t < 8; ++t) R[t] = (f32x4){0.f, 0.f, 0.f, 0.f};
    float dtot0 = 1.f, dtot1 = 1.f;
    unsigned gr[8], vr[8];
#define SA_LOAD(cidx) do { const int _b = tfirst + (cidx) * cstride; _Pragma("unroll") for (int i = 0; i < 8; ++i) { const int tau = 8 * tg + i; const int tok = dir ? (_b + 63 - tau) : (_b + tau); \
        const unsigned so = (unsigned)tok * 4096u; gr[i] = BLD32(rsG, coffb, so); vr[i] = BLD32(rsV, coffb, so); } } while (0)
#define SA_H2F(x) ((float)__builtin_bit_cast(_Float16, (unsigned short)(x)))
#define SA_BAR() do { asm volatile("s_waitcnt lgkmcnt(0)" ::: "memory"); __builtin_amdgcn_s_barrier(); asm volatile("" ::: "memory"); } while (0)
    SA_LOAD(0);
#pragma unroll 1
    for (int c = 0; c < nch; ++c) {
        float k0[8], k1[8]; float gp0 = 1.f, gp1 = 1.f;
#pragma unroll
        for (int i = 0; i < 8; ++i) { k0[i] = SA_H2F(gr[i] & 0xffffu); k1[i] = SA_H2F(gr[i] >> 16); gp0 *= 1.0f - k0[i]; gp1 *= 1.0f - k1[i]; }
        *(LAS f32x2*)(L + SC_QTOT + (tg * 128 + 2 * cp) * 4) = (f32x2){gp0, gp1};
        unsigned vc0[4], vc1[4];
#pragma unroll
        for (int i = 1; i < 8; i += 2) { vc0[i >> 1] = __builtin_amdgcn_perm(vr[i], vr[i - 1], 0x05040100u); vc1[i >> 1] = __builtin_amdgcn_perm(vr[i], vr[i - 1], 0x07060302u); }
        SA_BAR();
        *(LAS v4u*)(L + SC_VT + (2 * cp) * 144 + tg * 16) = (v4u){vc0[0], vc0[1], vc0[2], vc0[3]}; *(LAS v4u*)(L + SC_VT + (2 * cp + 1) * 144 + tg * 16) = (v4u){vc1[0], vc1[1], vc1[2], vc1[3]};
        float sfx0 = 1.f, sfx1 = 1.f, gl0 = 1.f, gl1 = 1.f;
#pragma unroll
        for (int g = 0; g < 8; ++g) { const f32x2 t = *(const LAS f32x2*)(L + SC_QTOT + (g * 128 + 2 * cp) * 4);
            if (g > tg) { sfx0 *= t.x; sfx1 *= t.y; } gl0 *= t.x; gl1 *= t.y; }
        unsigned kc0[4], kc1[4]; float kh0[8], kh1[8];
#pragma unroll
        for (int i = 7; i >= 0; --i) { kh0[i] = k0[i] * sfx0; kh1[i] = k1[i] * sfx1; sfx0 *= 1.0f - k0[i]; sfx1 *= 1.0f - k1[i]; }
#pragma unroll
        for (int i = 0; i < 4; ++i) { kc0[i] = pg8::cvt_pk_bf16(kh0[2 * i], kh0[2 * i + 1]); kc1[i] = pg8::cvt_pk_bf16(kh1[2 * i], kh1[2 * i + 1]); }
        *(LAS v4u*)(L + SC_KTT + (2 * cp) * 144 + tg * 16) = (v4u){kc0[0], kc0[1], kc0[2], kc0[3]}; *(LAS v4u*)(L + SC_KTT + (2 * cp + 1) * 144 + tg * 16) = (v4u){kc1[0], kc1[1], kc1[2], kc1[3]};
        if (tg == 0) { *(LAS f32x2*)(L + SC_FAC + (2 * cp) * 4) = (f32x2){gl0, gl1}; dtot0 *= gl0; dtot1 *= gl1; }
        if (c + 1 < nch) SA_LOAD(c + 1);
        SA_BAR();
#pragma unroll
        for (int t = 0; t < 8; ++t) { const f32x4 f = *(const LAS f32x4*)(L + SC_FAC + (16 * t + 4 * h4) * 4); R[t] = R[t] * f; }
        bf16x8 vb[2];
#pragma unroll
        for (int ss = 0; ss < 2; ++ss) vb[ss] = *(const LAS bf16x8*)(L + SC_VT + (16 * w + l15) * 144 + (32 * ss + 8 * h4) * 2);
#pragma unroll
        for (int gq = 0; gq < 2; ++gq) { bf16x8 kk[4][2];
#pragma unroll
            for (int t = 0; t < 4; ++t)
#pragma unroll
                for (int ss = 0; ss < 2; ++ss) kk[t][ss] = *(const LAS bf16x8*)(L + SC_KTT + (16 * (4 * gq + t) + l15) * 144 + (32 * ss + 8 * h4) * 2);
            __builtin_amdgcn_sched_barrier(0);
#pragma unroll
            for (int t = 0; t < 4; ++t)
#pragma unroll
                for (int ss = 0; ss < 2; ++ss) R[4 * gq + t] = __builtin_amdgcn_mfma_f32_16x16x32_bf16(kk[t][ss], vb[ss], R[4 * gq + t], 0, 0, 0); }
    }
    if (dt_out && tg == 0) *(f32x2*)(dt_out + 2 * cp) = (f32x2){dtot0, dtot1};
#pragma unroll
    for (int t = 0; t < 8; ++t)
#pragma unroll
        for (int r = 0; r < 4; ++r) st_out[w * 2048 + (t * 4 + r) * 64 + lane] = R[t][r];
    SA_BAR();
#undef SA_LOAD
#undef SA_H2F
#undef SA_BAR
}

struct Args { const float* in[16]; float* out; unsigned char* ws; int ph_lo, ph_hi; };
constexpr int NPHASES = 23;

__global__ void __launch_bounds__(NTHREADS, 2) mk_fwd(Args args) {
    extern __shared__ __attribute__((aligned(16))) unsigned char lds[];
    Frame F;
    F.lds = (LAS unsigned char*)lds;
    F.tid = threadIdx.x; F.lane = F.tid & 63; F.wave = __builtin_amdgcn_readfirstlane(F.tid >> 6);
    F.G = gridDim.x; F.gw = blockIdx.x * NWAVES + F.wave; F.NGW = F.G * NWAVES;
#pragma unroll
    for (int i = 0; i < 16; ++i) F.in[i] = args.in[i];
    F.out = args.out; F.ws = args.ws;
    unsigned char* ws = args.ws;
    volatile LAS unsigned* MISC = (volatile LAS unsigned*)(F.lds + MISC_OFF);
    for (int u = F.tid; u < 256; u += NTHREADS) MISC[u] = 0u;
    __syncthreads();
    XcdBarrier bar = xcd_barrier_post((unsigned*)(ws + WS_CTL) + CW_BAR, MISC + 8);
    const int lo = args.ph_lo, hi = args.ph_hi;
#ifndef MK_PHMASK
#define MK_PHMASK 0xffffffffu
#endif
#define IN(k) ((((MK_PHMASK) >> (k)) & 1u) && lo <= (k) && (k) < hi)
#define SEAM(k) do { if (IN(k) && IN((k) + 1)) xcd_barrier(bar); } while (0)
#ifndef MK_DUP
#define MK_DUP 0u
#endif
#define DUPN(k) (1 + (int)(((MK_DUP) >> (k)) & 1u))
#define PH_BEGIN(k) if (IN(k)) { for (int _rep = 0; _rep < DUPN(k); ++_rep) { if (_rep) xcd_barrier(bar);
#define PH_END(k) } } SEAM(k);

    const float* mod = (const float*)(ws + WS_MOD);
    const float* ONES = (const float*)(ws + WS_VEC); const float* ZEROS = ONES + D;
    float* RS = (float*)(ws + WS_RS); float* SLAB = (float*)(ws + WS_SLAB);
    _Float16* ZA = (_Float16*)(ws + WS_ZA); _Float16* ZB = (_Float16*)(ws + WS_ZB);
    bf16* H = (bf16*)(ws + WS_H); bf16* HID = (bf16*)(ws + WS_HID); bf16* PB = (bf16*)(ws + WS_HID); bf16* H8 = (bf16*)(ws + WS_H8);
    bf16* HF = F8_IN ? H8 : H;
    const bf16* W1T = (const bf16*)(ws + WS_W1T); const bf16* W2T = (const bf16*)(ws + WS_W2T);
    const float* lng = F.in[6]; const float* lnb = F.in[7];
    const int bx = (int)blockIdx.x;

#define MODP(layer, which) (mod + (size_t)((layer) * 2 + (which)) * NMOD)
#define GEMM_FFN_IN(k, mi, rows, cstage) PH_BEGIN(k) pg8::Gemm g{F8_IN ? (const void*)H8 : (const void*)H, (const unsigned char*)(ws + WS_W1T) + (size_t)(mi) * W1T_STRIDE * 2, F8_IN ? D : 2 * D, F8_IN ? D : 2 * D, 31, 0}; \
        pg8::StaticOrder S; S.init(rows, 2 * DFF, F8_IN ? D / 2 : D, F.G, bx); \
        pg8::EpiSwiglu<F8_IN, F8_OUT> E{HID, DFF}; pg8::gemm_phase<pg8::EpiSwiglu<F8_IN, F8_OUT>, pg8::StaticOrder, F8_IN>(F.lds + RING_OFF, g, S, E); \
        if ((cstage) > 0 && _rep == 0) { const int nbusy = S.nwg % F.G; if (bx >= nbusy) { conv_stage(F, cstage, (bx - nbusy) * NWAVES + F.wave, (F.G - nbusy) * NWAVES, 1); \
            if ((k) == 2) conv_stage(F, 0, (bx - nbusy) * NWAVES + F.wave, (F.G - nbusy) * NWAVES, 2); \
            if ((k) == 8) { __syncthreads(); LAS float* sv_ = (LAS float*)(F.lds + SVEC_OFF); for (int i_ = F.tid; i_ < 2 * D; i_ += NTHREADS) { const float x_ = (i_ < D) ? F.in[1][i_] : F.in[3][i_ - D]; sv_[i_] = pg8::fsilu(x_); } \
                __syncthreads(); mod_gemv(F, sv_, 1, MOD1_CUT, 72 * D, (bx - nbusy) * NWAVES + F.wave, (F.G - nbusy) * NWAVES); } } } PH_END(k)
#define FFN_OUT_GEMM pg8::Gemm g{HID, (const unsigned char*)(ws + WS_W2T) + (size_t)(mi_) * W2T_STRIDE * 2, F8_OUT ? DFF : 2 * DFF, F8_OUT ? DFF : 2 * DFF, 31, 0}
#define GEMM_FFN_OUT(k, mi, rows, zpl, zpc, lgp, lbp, layer, sub, zo) PH_BEGIN(k) const int mi_ = (mi); FFN_OUT_GEMM; pg8::StaticOrder S; S.init(rows, D, F8_OUT ? DFF / 2 : DFF, F.G, bx); \
        pg8::EpiResid<1, F8_OUT ? 11 : 0> E{zpl, zpc, 64, RS, lgp, lbp, MODP(layer, 0) + (size_t)((sub) * 3 + 2) * D, MODP(layer, 1) + (size_t)((sub) * 3 + 2) * D, nullptr, zo}; \
        pg8::gemm_phase<pg8::EpiResid<1, F8_OUT ? 11 : 0>, pg8::StaticOrder, F8_OUT>(F.lds + RING_OFF, g, S, E); PH_END(k)
#define GEMM_FFN_OUT_CTX(k, mi, zpl, ZF32K, lgp, lbp, layer, sub, zo) PH_BEGIN(k) const int mi_ = (mi); FFN_OUT_GEMM; pg8::SplitCtxOrder S; S.init2(SEQ, D, F8_OUT ? DFF / 2 : DFF, F.G, bx, 64, NSPLIT); \
        pg8::EpiResidSplit<1, F8_OUT ? 11 : 0, ZF32K> E{{zpl, zpl, 64, RS, lgp, lbp, MODP(layer, 0) + (size_t)((sub) * 3 + 2) * D, MODP(layer, 1) + (size_t)((sub) * 3 + 2) * D, nullptr, zo}, SLAB, F8_OUT ? DFF / 128 : DFF / 64}; \
        pg8::gemm_phase<pg8::EpiResidSplit<1, F8_OUT ? 11 : 0, ZF32K>, pg8::SplitCtxOrder, F8_OUT>(F.lds + RING_OFF, g, S, E); \
        if (_rep == 0 && bx >= 8 * NSPLIT) conv_stage(F, (k) == 3 ? 1 : ((k) == 9 ? 2 : 3), (bx - 8 * NSPLIT) * NWAVES + F.wave, (F.G - 8 * NSPLIT) * NWAVES, 2); PH_END(k)

    PH_BEGIN(0) p0_prologue(F, _rep == 0); PH_END(0)
    PH_BEGIN(1) t_rows<0, false, F8_IN>(F, F.in[0], F.in[2], nullptr, nullptr, MODP(0, 0), MODP(0, 1), 0, HF, nullptr, RS, MALL); PH_END(1)
    GEMM_FFN_IN(2, 0, MALL, 1)
    GEMM_FFN_OUT_CTX(3, 0, F.in[0], true, ONES, ZEROS, 0, 0, ZA)
    PH_BEGIN(4) t_rows<1, true, false, true>(F, ZA, ZA + (size_t)SEQ * D, lng + 0 * D, lnb + 0 * D, MODP(0, 0), MODP(0, 1), 1, H, nullptr, RS, MALL, CtxComb{SLAB, F.in[2], ONES, ZEROS, MODP(0, 1) + (size_t)(0 * 3 + 2) * D, ZA + (size_t)SEQ * D}); PH_END(4)
    PH_BEGIN(5) tp_pool(F, H, PB); PH_END(5)
    PH_BEGIN(6) { pg8::Gemm g{PB, (const bf16*)(ws + WS_WPT), 2 * D, 2 * 512, 1, 2 * 512}; pg8::StaticOrder S; S.init(MALL, D, 512, F.G, bx);
        pg8::EpiResid<2> E{ZA, ZA + (size_t)SEQ * D, 64, RS, lng + 0 * D, lnb + 0 * D, MODP(0, 0) + (size_t)(1 * 3 + 2) * D, MODP(0, 1) + (size_t)(1 * 3 + 2) * D, F.in[11], ZB};
        pg8::gemm_phase<pg8::EpiResid<2>, pg8::StaticOrder>(F.lds + RING_OFF, g, S, E);
        if (_rep == 0) { const int nbusy = S.nwg % F.G; if (bx >= nbusy) {
            LAS float* sv = (LAS float*)(F.lds + SVEC_OFF);
            for (int i = F.tid; i < 2 * D; i += NTHREADS) { const float x = (i < D) ? F.in[1][i] : F.in[3][i - D]; sv[i] = pg8::fsilu(x); }
            __syncthreads();
            mod_gemv(F, sv, 1, 0, MOD1_CUT, (bx - nbusy) * NWAVES + F.wave, (F.G - nbusy) * NWAVES); } } }
    PH_END(6)
    PH_BEGIN(7) t_rows<1, false, F8_IN>(F, ZB, ZB + (size_t)SEQ * D, lng + 1 * D, lnb + 1 * D, MODP(0, 0), MODP(0, 1), 2, HF, nullptr, RS, MALL); PH_END(7)
    GEMM_FFN_IN(8, 1, MALL, 2)
    GEMM_FFN_OUT_CTX(9, 1, ZB, false, lng + 1 * D, lnb + 1 * D, 0, 2, ZA)
    PH_BEGIN(10) t_rows<1, true, F8_IN>(F, ZA, ZA + (size_t)SEQ * D, lng + 2 * D, lnb + 2 * D, MODP(1, 0), MODP(1, 1), 0, HF, nullptr, RS, MALL, CtxComb{SLAB, ZB + (size_t)SEQ * D, lng + 1 * D, lnb + 1 * D, MODP(0, 1) + (size_t)(2 * 3 + 2) * D, ZA + (size_t)SEQ * D}); PH_END(10)
    GEMM_FFN_IN(11, 2, MALL, 3)
    GEMM_FFN_OUT_CTX(12, 2, ZA, false, lng + 2 * D, lnb + 2 * D, 1, 0, ZB)
    PH_BEGIN(13) t_rows<1, true>(F, ZB, ZB + (size_t)SEQ * D, lng + 3 * D, lnb + 3 * D, MODP(1, 0), MODP(1, 1), 1, H, nullptr, RS, MALL, CtxComb{SLAB, ZA + (size_t)SEQ * D, lng + 2 * D, lnb + 2 * D, MODP(1, 1) + (size_t)(0 * 3 + 2) * D, ZB + (size_t)SEQ * D}); PH_END(13)
    ScanT ST;
    ST.Q = (const bf16*)(ws + WS_Q); ST.V = (const bf16*)(ws + WS_V); ST.G0 = (const unsigned short*)(ws + WS_GF); ST.G1 = (const unsigned short*)(ws + WS_GB); ST.OG = (const bf16*)(ws + WS_OG);
    ST.OF = (float*)(ws + WS_HID); ST.YG = H; ST.ST = (float*)(ws + WS_ST); ST.CST = (float*)(ws + WS_CST); ST.DT = (float*)(ws + WS_DT); ST.normg = F.in[14];
    PH_BEGIN(14) { pg8::Gemm g{H, (const bf16*)(ws + WS_WHI), 2 * D, 2 * D, 31, 0}; pg8::StaticOrder S; S.init(MALL, 5 * D, D, F.G, bx);
        pg8::EpiHgrn E{(bf16*)(ws + WS_Q), (bf16*)(ws + WS_V), (unsigned short*)(ws + WS_GF), (unsigned short*)(ws + WS_GB), (bf16*)(ws + WS_OG), F.in[13], D};
        pg8::gemm_phase<pg8::EpiHgrn, pg8::StaticOrder>(F.lds + RING_OFF, g, S, E);
        if (_rep == 0) { const int nbusy = S.nwg % F.G; if (bx >= nbusy) conv_stage(F, 4, (bx - nbusy) * NWAVES + F.wave, (F.G - nbusy) * NWAVES); } }
    PH_END(14)
    PH_BEGIN(15) {
#pragma unroll 1
        for (int u = bx; u < 544; u += F.G) {
            if (u < 512) { const int hd = u >> 4, seg = u & 15, h = hd >> 1, dir = hd & 1;
                scan_state_unit(F, ST, h, dir, dir ? seg * SEGLEN + SEGLEN - CHUNK : seg * SEGLEN, dir ? -CHUNK : CHUNK, SEGLEN / CHUNK, ST.ST + (size_t)(hd * NSEG + seg) * 16384, ST.DT + (size_t)(hd * NSEG + seg) * 128);
            } else { const int hd = u - 512, h = hd >> 1, dir = hd & 1;
                scan_state_unit(F, ST, h, dir, dir ? SEQ + CTXL - CHUNK : SEQ, dir ? -CHUNK : CHUNK, CTXL / CHUNK, ST.CST + (size_t)hd * 16384, nullptr); }
        }
    }
    PH_END(15)
    PH_BEGIN(16) {
        for (int gt = bx * NTHREADS + F.tid; gt < 32 * 4096; gt += F.G * NTHREADS) {
            const int hd = gt >> 12, e4 = (gt & 4095) * 4, dir = hd & 1;
            const int tr = (e4 >> 6) & 31, ln = e4 & 63, k = 16 * (tr >> 2) + 4 * (ln >> 4) + (tr & 3);
            f32x4 carry = *(const f32x4*)(ST.CST + (size_t)hd * 16384 + e4);
            f32x4 tmp[NSEG]; float dcy[NSEG];
#pragma unroll
            for (int j = 0; j < NSEG; ++j) { const int seg = dir ? (NSEG - 1 - j) : j; tmp[j] = *(const f32x4*)(ST.ST + (size_t)(hd * NSEG + seg) * 16384 + e4); dcy[j] = ST.DT[(size_t)(hd * NSEG + seg) * 128 + k]; }
#pragma unroll
            for (int j = 0; j < NSEG; ++j) { const int seg = dir ? (NSEG - 1 - j) : j; *(f32x4*)(ST.ST + (size_t)(hd * NSEG + seg) * 16384 + e4) = carry; carry = carry * dcy[j] + tmp[j]; }
        }
    }
    PH_END(16)
    PH_BEGIN(17) {
#pragma unroll 1
        for (int u = bx; u < 256; u += F.G) { const int h = u >> 4, seg = u & 15;
            scan_unit<true>(F, ST, h, 0, seg * SEGLEN, CHUNK, SEGLEN / CHUNK, ST.ST + (size_t)((h * 2 + 0) * NSEG + seg) * 16384, nullptr, nullptr);
            VM_WAIT(); __syncthreads();
            scan_unit<true>(F, ST, h, 1, seg * SEGLEN + SEGLEN - CHUNK, -CHUNK, SEGLEN / CHUNK, ST.ST + (size_t)((h * 2 + 1) * NSEG + seg) * 16384, nullptr, nullptr); }
    }
    PH_END(17)
    PH_BEGIN(18) { pg8::Gemm g{H, (const bf16*)(ws + WS_WHO), 2 * D, 2 * D, 31, 0}; pg8::StaticOrder S; S.init(SEQ, D, D, F.G, bx);
        pg8::EpiResid<2> E{ZB, ZB + (size_t)SEQ * D, 64, RS, lng + 3 * D, lnb + 3 * D, MODP(1, 0) + (size_t)(1 * 3 + 2) * D, MODP(1, 1) + (size_t)(1 * 3 + 2) * D, nullptr, ZA};
        pg8::gemm_phase<pg8::EpiResid<2>, pg8::StaticOrder>(F.lds + RING_OFF, g, S, E); }
    PH_END(18)
    PH_BEGIN(19) t_rows<1, false, F8_IN>(F, ZA, ZA + (size_t)SEQ * D, lng + 4 * D, lnb + 4 * D, MODP(1, 0), MODP(1, 1), 2, HF, nullptr, RS, SEQ); PH_END(19)
    GEMM_FFN_IN(20, 3, SEQ, 0)
    GEMM_FFN_OUT(21, 3, SEQ, ZA, ZA + (size_t)SEQ * D, lng + 4 * D, lnb + 4 * D, 1, 2, ZB)
    PH_BEGIN(22) t_rows<2>(F, ZB, ZB + (size_t)SEQ * D, lng + 5 * D, lnb + 5 * D, nullptr, nullptr, 0, nullptr, F.out, RS, SEQ); } }
#undef IN
#undef SEAM
}

#ifndef MK_CUTS
#define MK_CUTS 0
#endif
extern "C" void kernel_launch(void* const* d_in, const int* in_sizes, int n_in, void* d_out, int out_size, void* d_ws, size_t ws_size, hipStream_t stream) {
    static int grid = 0;
    if (grid == 0) {
        if (n_in != 16 || out_size != SEQ * D || ws_size < WS_END) { fprintf(stderr, "kernel_launch: unexpected shapes (n_in %d out %d ws %zu)\n", n_in, out_size, ws_size); grid = -1; return; }
        int dev = 0, cus = 0, per_cu = 0;
        if (hipGetDevice(&dev) != hipSuccess || hipDeviceGetAttribute(&cus, hipDeviceAttributeMultiprocessorCount, dev) != hipSuccess) { grid = -1; return; }
        if (hipFuncSetAttribute((const void*)mk_fwd, hipFuncAttributeMaxDynamicSharedMemorySize, LDS_BYTES) != hipSuccess) { fprintf(stderr, "kernel_launch: hipFuncSetAttribute failed\n"); grid = -1; return; }
        if (hipOccupancyMaxActiveBlocksPerMultiprocessor(&per_cu, (const void*)mk_fwd, NTHREADS, LDS_BYTES) != hipSuccess || per_cu < 1) { fprintf(stderr, "kernel_launch: occupancy query says %d\n", per_cu); }
        (void)hipGetLastError();
        grid = cus;
    }
    if (grid < 0) return;
    (void)hipMemsetAsync((char*)d_ws + WS_CTL, 0, CTL_ZERO_BYTES, stream);
    Args a{};
    for (int i = 0; i < 16; ++i) a.in[i] = (const float*)d_in[i];
    a.out = (float*)d_out; a.ws = (unsigned char*)d_ws;
#if MK_CUTS
    for (int p = 0; p < NPHASES; ++p) { a.ph_lo = p; a.ph_hi = p + 1; hipLaunchKernelGGL(mk_fwd, dim3(grid), dim3(NTHREADS), LDS_BYTES, stream, a); }
#else
    a.ph_lo = 0; a.ph_hi = NPHASES;
    hipLaunchKernelGGL(mk_fwd, dim3(grid), dim3(NTHREADS), LDS_BYTES, stream, a);
#endif
}
```

```cpp
#include <hip/hip_runtime.h>
#include <cstdio>
#include <cstdint>

namespace pg8 {
#define PG8_LAS __attribute__((address_space(3)))
typedef unsigned short bf16_t;
typedef short bf16x8 __attribute__((ext_vector_type(8)));
typedef float f32x4 __attribute__((ext_vector_type(4)));
typedef float f32x2 __attribute__((ext_vector_type(2)));
typedef unsigned u32x4 __attribute__((ext_vector_type(4)));
typedef unsigned u32x2 __attribute__((ext_vector_type(2)));
typedef short bf16x16 __attribute__((ext_vector_type(16)));
typedef int i32x8 __attribute__((ext_vector_type(8)));
typedef int i32x4 __attribute__((ext_vector_type(4)));
constexpr int BM = 256, BK = 64, HALF = 128, HTB = HALF * BK * 2, STAGE_BYTES = 8 * HTB, NXCD = 8, WGM = 8;

template <int SW = 5> __host__ __device__ __forceinline__ int lds_byte(int r, int c) { const int st = (r >> 4) * 2 + (c >> 5), rr = r & 15, cc = c & 31, ob = rr * 64 + cc * 2; return st * 1024 + (ob ^ (((ob >> 9) & 1) << SW)); }
template <int SW = 5> __host__ __device__ __forceinline__ void stage_rc(int b, int& R, int& C) { const int st = b / 1024, sb = b % 1024, swz = sb ^ (((sb >> 9) & 1) << SW); R = (st >> 1) * 16 + swz / 64; C = (st & 1) * 32 + (swz % 64) / 2; }
__host__ __device__ __forceinline__ int perm32(int rho) { const int n = rho >> 4, i = rho & 15; return 8 * (i >> 2) + 4 * n + (i & 3); }

struct Unit { int pm, pn, kt0, nt; };
struct Gemm { const void* A; const void* Bt; int lda, ldb, grp_shift, grp_bytes; };

struct StaticOrder {
    int nM, nN, nwg, G, c, ntf;
    __host__ __device__ void init(int M, int N, int K, int G_, int c_) { nM = M / BM; nN = N / BM; nwg = nM * nN; G = G_; c = c_; ntf = K / BK; }
    __host__ __device__ bool next(int i, Unit& u) const {
        const long L = (long)i * G + c; if (L >= nwg) return false;
        u.kt0 = 0; u.nt = ntf;
        int wgid = (int)L; { const int q = nwg / NXCD, r = nwg % NXCD, xcd = wgid % NXCD, off = wgid / NXCD; wgid = (xcd < r ? xcd * (q + 1) : r * (q + 1) + (xcd - r) * q) + off; }
        const int nig = WGM * nN, gid = wgid / nig, fm = gid * WGM, gsz = (nM - fm) < WGM ? (nM - fm) : WGM;
        u.pm = fm + ((wgid % nig) % gsz); u.pn = (wgid % nig) / gsz; return true;
    }
};

struct SplitCtxOrder : StaticOrder {
    int ctx_pm, nsplit, nts;
    __host__ __device__ void init2(int M, int N, int K, int G_, int c_, int ctx_pm_, int nsplit_) { init(M, N, K, G_, c_); ctx_pm = ctx_pm_; nsplit = nsplit_; nts = ntf / nsplit_; }
    __host__ __device__ bool next(int i, Unit& u) const {
        Unit a = {0, 0, 0, 0}; const bool ok = StaticOrder::next(i, a);
        const long e = (long)i * G + c - nwg; const bool ok2 = (e >= 0) && (e < (long)nN * nsplit);
        const int en = ok2 ? (int)e : 0;
        u.pm = ok ? a.pm : ctx_pm; u.pn = ok ? a.pn : (en % nN); u.kt0 = ok ? 0 : (en / nN) * nts; u.nt = ok ? ntf : nts;
        return ok || ok2;
    }
};

typedef __bf16 bf16x2_t __attribute__((ext_vector_type(2)));
__device__ __forceinline__ unsigned cvt_pk_bf16(float lo, float hi) { const f32x2 v = {lo, hi}; return __builtin_bit_cast(unsigned, __builtin_convertvector(v, bf16x2_t)); }
__device__ __forceinline__ float fsilu(float x) { return x * __builtin_amdgcn_rcpf(1.0f + __builtin_amdgcn_exp2f(-1.4426950408889634f * x)); }
__device__ __forceinline__ float fsigm(float x) { return __builtin_amdgcn_rcpf(1.0f + __builtin_amdgcn_exp2f(-1.4426950408889634f * x)); }


__device__ __forceinline__ unsigned cvt4_fp8(float a, float b, float c, float d) { int r = __builtin_amdgcn_cvt_pk_fp8_f32(a, b, 0, false); r = __builtin_amdgcn_cvt_pk_fp8_f32(c, d, r, true); return (unsigned)r; }
template <bool F8IN, bool F8> struct EpiSwiglu {
    static constexpr bool PERM = true;
    static constexpr float IN_SCALE = F8IN ? (1.0f / 64.0f) : 1.0f, OUT_SCALE = F8 ? 16.0f : 1.0f;
    void* O; int ldo;
    __device__ __forceinline__ u32x2 hid8(const f32x4 a0, const f32x4 a1, const f32x4 u0, const f32x4 u1) const {
        constexpr float KS = 1.0f / (IN_SCALE * IN_SCALE * OUT_SCALE), C1 = -1.4426950408889634f * IN_SCALE;
        const f32x4 t0 = a0 * C1, t1 = a1 * C1;
        const f32x4 e0 = {__builtin_amdgcn_exp2f(t0[0]), __builtin_amdgcn_exp2f(t0[1]), __builtin_amdgcn_exp2f(t0[2]), __builtin_amdgcn_exp2f(t0[3])};
        const f32x4 e1 = {__builtin_amdgcn_exp2f(t1[0]), __builtin_amdgcn_exp2f(t1[1]), __builtin_amdgcn_exp2f(t1[2]), __builtin_amdgcn_exp2f(t1[3])};
        const f32x4 d0 = e0 * KS + KS, d1 = e1 * KS + KS;
        const f32x4 r0 = {__builtin_amdgcn_rcpf(d0[0]), __builtin_amdgcn_rcpf(d0[1]), __builtin_amdgcn_rcpf(d0[2]), __builtin_amdgcn_rcpf(d0[3])};
        const f32x4 r1 = {__builtin_amdgcn_rcpf(d1[0]), __builtin_amdgcn_rcpf(d1[1]), __builtin_amdgcn_rcpf(d1[2]), __builtin_amdgcn_rcpf(d1[3])};
        const f32x4 h0 = (a0 * u0) * r0, h1 = (a1 * u1) * r1;
        u32x2 w; w.x = cvt4_fp8(h0[0], h0[1], h0[2], h0[3]); w.y = cvt4_fp8(h1[0], h1[1], h1[2], h1[3]); return w;
    }
    __device__ __forceinline__ void operator()(const f32x4 (&acc)[2][2][4][2], const Unit& u, int wr, int wc, int fr, int fq) const {
        const int row0 = u.pm * BM + wr * 64 + fr, col0 = u.pn * HALF + wc * 32 + 8 * fq;
        if constexpr (F8) {
            unsigned char* base = (unsigned char*)O + (size_t)(row0 + (fq & 1) * 16) * ldo + (col0 - 8 * (fq & 1));
#pragma unroll
            for (int ai = 0; ai < 2; ++ai)
#pragma unroll
                for (int mp = 0; mp < 2; ++mp) {
                    const u32x2 wa = hid8(acc[ai][0][2 * mp][0], acc[ai][0][2 * mp][1], acc[ai][1][2 * mp][0], acc[ai][1][2 * mp][1]);
                    const u32x2 wb = hid8(acc[ai][0][2 * mp + 1][0], acc[ai][0][2 * mp + 1][1], acc[ai][1][2 * mp + 1][0], acc[ai][1][2 * mp + 1][1]);
                    const auto sx = __builtin_amdgcn_permlane16_swap(wa.x, wb.x, false, false), sy = __builtin_amdgcn_permlane16_swap(wa.y, wb.y, false, false);
                    u32x4 w; w.x = sx[0]; w.y = sy[0]; w.z = sx[1]; w.w = sy[1];
                    *(u32x4*)(base + (size_t)(ai * HALF + mp * 32) * ldo) = w;
                }
        } else {
#pragma unroll
            for (int ai = 0; ai < 2; ++ai)
#pragma unroll
                for (int m = 0; m < 4; ++m) {
                    constexpr float KS = 1.0f / (IN_SCALE * IN_SCALE * OUT_SCALE), C1 = -1.4426950408889634f * IN_SCALE;
                    const f32x4 a0 = acc[ai][0][m][0], a1 = acc[ai][0][m][1], u0 = acc[ai][1][m][0], u1 = acc[ai][1][m][1];
                    float h0[4], h1[4];
#pragma unroll
                    for (int j = 0; j < 4; ++j) { h0[j] = (a0[j] * u0[j]) * __builtin_amdgcn_rcpf(KS + KS * __builtin_amdgcn_exp2f(a0[j] * C1)); h1[j] = (a1[j] * u1[j]) * __builtin_amdgcn_rcpf(KS + KS * __builtin_amdgcn_exp2f(a1[j] * C1)); }
                    bf16_t* rowp = (bf16_t*)O + (size_t)(row0 + ai * HALF + m * 16) * ldo + col0;
                    u32x4 w; w.x = cvt_pk_bf16(h0[0], h0[1]); w.y = cvt_pk_bf16(h0[2], h0[3]); w.z = cvt_pk_bf16(h1[0], h1[1]); w.w = cvt_pk_bf16(h1[2], h1[3]);
                    *(u32x4*)rowp = w;
                }
        }
    }
};

typedef _Float16 f16x8 __attribute__((ext_vector_type(8)));
typedef _Float16 f16x4 __attribute__((ext_vector_type(4)));
template <int COEF_HALVES, int ACC_SHIFT = 0, bool ZPF32 = false> struct EpiResid {
    static constexpr bool PERM = true;
    static constexpr float coefs = 0.5f * COEF_HALVES / (float)(1 << ACC_SHIFT), alpha = 1.4142135623730951f; static constexpr int ld = 2048;
    const void* zp_lat; const void* zp_ctx;
    int ctx_pm;
    const float* rs;
    const float* lg; const float* lb;
    const float* gate_lat; const float* gate_ctx;
    const float* coefv;
    _Float16* zout;
    __device__ __forceinline__ void operator()(const f32x4 (&acc)[2][2][4][2], const Unit& u, int wr, int wc, int fr, int fq) const {
        const bool isctx = (u.pm == ctx_pm);
        const char* zp = (const char*)(isctx ? zp_ctx : zp_lat) - (isctx ? (size_t)ctx_pm * BM * ld * (ZPF32 ? 4 : 2) : 0);
        const float* gate = isctx ? gate_ctx : gate_lat;
        const int row0 = u.pm * BM + wr * 64 + fr, col0 = u.pn * BM + wc * 32 + 8 * fq;
        constexpr int RD = ZPF32 ? 2 : 3;
        f32x4 zf[ZPF32 ? RD : 1][2]; f16x8 zh[ZPF32 ? 1 : RD]; f32x2 st[RD];
#define ER_LOAD(j_, b_) do { const int r_ = row0 + (((j_) >> 2) & 1) * HALF + ((j_) & 3) * 16; const size_t off_ = (size_t)r_ * ld + col0 + ((j_) >> 3) * HALF; st[b_] = *(const f32x2*)(rs + 2 * (size_t)r_); \
            if constexpr (ZPF32) { zf[b_][0] = *(const f32x4*)((const float*)zp + off_); zf[b_][1] = *(const f32x4*)((const float*)zp + off_ + 4); } else zh[b_] = *(const f16x8*)((const _Float16*)zp + off_); } while (0)
#pragma unroll
        for (int j = 0; j < RD; ++j) ER_LOAD(j, j);
        f32x4 lgA[2], lbA[2], gc[2];
#pragma unroll
        for (int j = 0; j < 16; ++j) { const int b = j % RD, bj = j >> 3, ai = (j >> 2) & 1, m = j & 3; const size_t off = (size_t)(row0 + ai * HALF + m * 16) * ld + col0 + bj * HALF;
            if ((j & 7) == 0) {
#pragma unroll
                for (int n = 0; n < 2; ++n) { const int c = col0 + bj * HALF + n * 4;
                    lgA[n] = *(const f32x4*)(lg + c) * alpha; lbA[n] = *(const f32x4*)(lb + c) * alpha;
                    f32x4 g = *(const f32x4*)(gate + c) * coefs; if (coefv) g = g * *(const f32x4*)(coefv + c); gc[n] = g; } }
            asm volatile("" ::: "memory"); __builtin_amdgcn_sched_barrier(0);
            f32x4 z0, z1;
            if constexpr (ZPF32) { z0 = zf[b][0]; z1 = zf[b][1]; }
            else { const f16x8 h = zh[b]; z0 = (f32x4){(float)h[0], (float)h[1], (float)h[2], (float)h[3]}; z1 = (f32x4){(float)h[4], (float)h[5], (float)h[6], (float)h[7]}; }
            const f32x4 o0 = ((z0 - st[b].x) * st[b].y) * lgA[0] + lbA[0] + gc[0] * acc[ai][bj][m][0];
            const f32x4 o1 = ((z1 - st[b].x) * st[b].y) * lgA[1] + lbA[1] + gc[1] * acc[ai][bj][m][1];
            const f16x8 oh = {(_Float16)o0[0], (_Float16)o0[1], (_Float16)o0[2], (_Float16)o0[3], (_Float16)o1[0], (_Float16)o1[1], (_Float16)o1[2], (_Float16)o1[3]};
            *(f16x8*)(zout + off) = oh;
            asm volatile("" ::: "memory"); __builtin_amdgcn_sched_barrier(0);
            if (j + RD < 16) ER_LOAD(j + RD, b);
        }
#undef ER_LOAD
    }
};

template <int COEF_HALVES, int ACC_SHIFT = 0, bool ZPF32 = false> struct EpiResidSplit {
    static constexpr bool PERM = true;
    EpiResid<COEF_HALVES, ACC_SHIFT, ZPF32> full; float* slab; int ntf;
    __device__ __forceinline__ void operator()(const f32x4 (&acc)[2][2][4][2], const Unit& u, int wr, int wc, int fr, int fq) const {
        if (u.nt == ntf) { full(acc, u, wr, wc, fr, fq); return; }
        float* sp = slab + (size_t)(u.kt0 / u.nt) * BM * 2048 + (size_t)(wr * 64 + fr) * 2048 + u.pn * BM + wc * 32 + 8 * fq;
#pragma unroll
        for (int ai = 0; ai < 2; ++ai)
#pragma unroll
            for (int m = 0; m < 4; ++m)
#pragma unroll
                for (int bj = 0; bj < 2; ++bj)
#pragma unroll
                    for (int n = 0; n < 2; ++n) *(f32x4*)(sp + (size_t)(ai * HALF + m * 16) * 2048 + bj * HALF + n * 4) = acc[ai][bj][m][n];
    }
};

struct EpiHgrn {
    static constexpr bool PERM = true;
    bf16_t* Q; bf16_t* V; unsigned short* GF; unsigned short* GB; bf16_t* OG; const float* lbraw;
    int ld;
    __device__ __forceinline__ void operator()(const f32x4 (&acc)[2][2][4][2], const Unit& u, int wr, int wc, int fr, int fq) const {
        const int sec = u.pn >> 3, colt = (u.pn & 7) * BM;
        const int row0 = u.pm * BM + wr * 64 + fr, col0 = colt + wc * 32 + 8 * fq;
        if (sec == 2 || sec == 3) {
            unsigned short* G = (sec == 2) ? GF : GB; const float* l0 = lbraw + (sec - 2) * 4096;
            f32x4 lbv[2][2];
#pragma unroll
            for (int bj = 0; bj < 2; ++bj)
#pragma unroll
                for (int n = 0; n < 2; ++n) { const int c = col0 + bj * HALF + 4 * n; const f32x4 a = *(const f32x4*)(l0 + c), b = *(const f32x4*)(l0 + 2048 + c);
#pragma unroll
                    for (int j = 0; j < 4; ++j) lbv[bj][n][j] = fsigm(b[j] - a[j]); }
#pragma unroll
            for (int ai = 0; ai < 2; ++ai)
#pragma unroll
                for (int m = 0; m < 4; ++m) { unsigned short* rowp = G + (size_t)(row0 + ai * HALF + m * 16) * ld + col0;
#pragma unroll
                    for (int bj = 0; bj < 2; ++bj) { _Float16 hv[8];
#pragma unroll
                        for (int n = 0; n < 2; ++n)
#pragma unroll
                            for (int j = 0; j < 4; ++j) { const float lbx = lbv[bj][n][j];
                                hv[n * 4 + j] = (_Float16)((1.0f - lbx) * fsigm(-acc[ai][bj][m][n][j])); }
                        u32x4 w;
                        w.x = (unsigned)__builtin_bit_cast(unsigned short, hv[0]) | ((unsigned)__builtin_bit_cast(unsigned short, hv[1]) << 16);
                        w.y = (unsigned)__builtin_bit_cast(unsigned short, hv[2]) | ((unsigned)__builtin_bit_cast(unsigned short, hv[3]) << 16);
                        w.z = (unsigned)__builtin_bit_cast(unsigned short, hv[4]) | ((unsigned)__builtin_bit_cast(unsigned short, hv[5]) << 16);
                        w.w = (unsigned)__builtin_bit_cast(unsigned short, hv[6]) | ((unsigned)__builtin_bit_cast(unsigned short, hv[7]) << 16);
                        *(u32x4*)(rowp + bj * HALF) = w; } }
        } else {
            bf16_t* O = (sec == 0) ? Q : (sec == 1 ? V : OG);
            const float sc = (sec == 0) ? 0.08838834764831845f : 1.0f;
#pragma unroll
            for (int ai = 0; ai < 2; ++ai)
#pragma unroll
                for (int m = 0; m < 4; ++m) { bf16_t* rowp = O + (size_t)(row0 + ai * HALF + m * 16) * ld + col0;
#pragma unroll
                    for (int bj = 0; bj < 2; ++bj) { f32x4 v0 = acc[ai][bj][m][0], v1 = acc[ai][bj][m][1];
                        if (sec != 1) {
#pragma unroll
                            for (int j = 0; j < 4; ++j) { v0[j] = fsilu(v0[j]) * sc; v1[j] = fsilu(v1[j]) * sc; } }
                        u32x4 w; w.x = cvt_pk_bf16(v0[0], v0[1]); w.y = cvt_pk_bf16(v0[2], v0[3]); w.z = cvt_pk_bf16(v1[0], v1[1]); w.w = cvt_pk_bf16(v1[2], v1[3]);
                        *(u32x4*)(rowp + bj * HALF) = w; } }
        }
    }
};

template <class Epi, class Sched, bool F8 = false, bool ALIGN_EPI = true>
__device__ __forceinline__ void gemm_phase(PG8_LAS unsigned char* lds, const Gemm g, const Sched S, const Epi E) {
    const int tid = threadIdx.x, wid = __builtin_amdgcn_readfirstlane(tid >> 6), lane = tid & 63, wr = wid >> 2, wc = wid & 3, fr = lane & 15, fq = lane >> 4;
    unsigned voffA[2], voffB[2];
#pragma unroll
    for (int i = 0; i < 2; ++i) { int R, C; stage_rc<F8 ? 4 : 5>(tid * 16 + i * 8192, R, C); const int Rb = Epi::PERM ? ((R & ~31) + perm32(R & 31)) : R;
        voffA[i] = (unsigned)(R * g.lda + C * 2); voffB[i] = (unsigned)(Rb * g.ldb + C * 2); }
    const size_t kstep = (size_t)(BK * 2);
    const size_t hstepA = (size_t)HALF * g.lda, hstepB = (size_t)HALF * g.ldb;
    const size_t tstepA = 2 * hstepA, tstepB = 2 * hstepB;
    const unsigned ldsw = (unsigned)wid * 1024u;
    const int aoff = lds_byte(wr * 64 + fr, fq * 8), boff = lds_byte(wc * 32 + fr, fq * 8);
    const int aoff8a = lds_byte<4>(wr * 64 + fr, fq * 16), aoff8b = lds_byte<4>(wr * 64 + fr, fq * 16 + 8), boff8a = lds_byte<4>(wc * 32 + fr, fq * 16), boff8b = lds_byte<4>(wc * 32 + fr, fq * 16 + 8);
#define PG8_SA(b, h) (((b) * 2 + (h)) * HTB)
#define PG8_SB(b, h) ((4 + (b) * 2 + (h)) * HTB)
#define PG8_STAGE(bufoff, gbase, voff) do { _Pragma("unroll") for (int _i = 0; _i < 2; ++_i) \
        __builtin_amdgcn_global_load_lds((const unsigned*)((const char*)(gbase) + (voff)[_i]), (PG8_LAS unsigned*)(lds + (bufoff) + ldsw + _i * 8192), 16, 0, 0); } while (0)
#define PG8_LDA(dst, b, h) do { if constexpr (F8) { _Pragma("unroll") for (int m = 0; m < 4; ++m) { dst[m][0] = *(const PG8_LAS bf16x8*)(lds + PG8_SA(b, h) + aoff8a + m * 2048); dst[m][1] = *(const PG8_LAS bf16x8*)(lds + PG8_SA(b, h) + aoff8b + m * 2048); } } \
        else { _Pragma("unroll") for (int m = 0; m < 4; ++m) _Pragma("unroll") for (int k = 0; k < 2; ++k) dst[m][k] = *(const PG8_LAS bf16x8*)(lds + PG8_SA(b, h) + aoff + m * 2048 + k * 1024); } } while (0)
#define PG8_LDB(dst, b, h) do { if constexpr (F8) { _Pragma("unroll") for (int n = 0; n < 2; ++n) { dst[n][0] = *(const PG8_LAS bf16x8*)(lds + PG8_SB(b, h) + boff8a + n * 2048); dst[n][1] = *(const PG8_LAS bf16x8*)(lds + PG8_SB(b, h) + boff8b + n * 2048); } } \
        else { _Pragma("unroll") for (int n = 0; n < 2; ++n) _Pragma("unroll") for (int k = 0; k < 2; ++k) dst[n][k] = *(const PG8_LAS bf16x8*)(lds + PG8_SB(b, h) + boff + n * 2048 + k * 1024); } } while (0)
#define PG8_F8FRAG(x) __builtin_shufflevector(__builtin_bit_cast(i32x4, x[0]), __builtin_bit_cast(i32x4, x[1]), 0, 1, 2, 3, 4, 5, 6, 7)
#define PG8_MMA(ai, bj, At, Bt) do { __builtin_amdgcn_s_setprio(1); if constexpr (F8) { _Pragma("unroll") for (int m = 0; m < 4; ++m) _Pragma("unroll") for (int n = 0; n < 2; ++n) \
            asm volatile("v_mfma_scale_f32_16x16x128_f8f6f4 %0, %1, %2, %0, %3, %3 op_sel_hi:[0,0,0]" : "+v"(acc[ai][bj][m][n]) : "v"(PG8_F8FRAG(Bt[n])), "v"(PG8_F8FRAG(At[m])), "v"(sc_one)); } \
        else { _Pragma("unroll") for (int m = 0; m < 4; ++m) _Pragma("unroll") for (int n = 0; n < 2; ++n) _Pragma("unroll") for (int k = 0; k < 2; ++k) \
            acc[ai][bj][m][n] = __builtin_amdgcn_mfma_f32_16x16x32_bf16(Bt[n][k], At[m][k], acc[ai][bj][m][n], 0, 0, 0); } __builtin_amdgcn_s_setprio(0); } while (0)
#define PG8_WAIT_V(n) asm volatile("s_waitcnt vmcnt(" #n ")" ::: "memory")
#define PG8_WAIT_L(n) asm volatile("s_waitcnt lgkmcnt(" #n ")" ::: "memory")
#define PG8_BAR __builtin_amdgcn_s_barrier()
#define PG8_SCHED __builtin_amdgcn_sched_barrier(0)
    Unit cur, nxt; int ui = 0;
    if (!S.next(0, cur)) return;
    int sc_one = 0x7f7f7f7f; asm volatile("" : "+v"(sc_one));
    (void)sc_one;
    f32x4 acc[2][2][4][2];
#pragma unroll
    for (int a = 0; a < 2; ++a)
#pragma unroll
        for (int b = 0; b < 2; ++b)
#pragma unroll
            for (int m = 0; m < 4; ++m)
#pragma unroll
                for (int n = 0; n < 2; ++n) acc[a][b][m][n] = (f32x4){0.f, 0.f, 0.f, 0.f};
    bf16x8 At[4][2], B0[2][2], B1[2][2];
    const char* cA = (const char*)g.A + (size_t)cur.pm * tstepA + (size_t)((cur.pn >> g.grp_shift) * g.grp_bytes) + (size_t)cur.kt0 * kstep; const char* cB = (const char*)g.Bt + (size_t)cur.pn * tstepB + (size_t)cur.kt0 * kstep;
    PG8_STAGE(PG8_SB(0, 0), cB, voffB); PG8_STAGE(PG8_SB(0, 1), cB + hstepB, voffB); PG8_STAGE(PG8_SA(0, 0), cA, voffA); PG8_STAGE(PG8_SA(0, 1), cA + hstepA, voffA);
    if (wr == 1) PG8_BAR;
    PG8_WAIT_V(2); PG8_BAR;
    PG8_STAGE(PG8_SB(1, 0), cB + kstep, voffB); PG8_STAGE(PG8_SA(1, 0), cA + kstep, voffA); PG8_STAGE(PG8_SB(1, 1), cB + hstepB + kstep, voffB);
    PG8_WAIT_V(6); PG8_BAR;
    for (;;) {
        const bool has_next = S.next(ui + 1, nxt);
        const char* nA = has_next ? (const char*)g.A + (size_t)nxt.pm * tstepA + (size_t)((nxt.pn >> g.grp_shift) * g.grp_bytes) + (size_t)nxt.kt0 * kstep : cA; const char* nB = has_next ? (const char*)g.Bt + (size_t)nxt.pn * tstepB + (size_t)nxt.kt0 * kstep : cB;
        const int nt = cur.nt;
        for (int t = 0; t < nt; t += 2) {
            const bool last = (t == nt - 2);
            const char* a1 = cA + (size_t)(t + 1) * kstep;
            const char* a2 = last ? nA : cA + (size_t)(t + 2) * kstep; const char* b2 = last ? nB : cB + (size_t)(t + 2) * kstep;
            const char* a3 = a2 + kstep; const char* b3 = b2 + kstep;
            PG8_LDB(B0, 0, 0); PG8_LDB(B1, 0, 1); PG8_SCHED; PG8_LDA(At, 0, 0); PG8_STAGE(PG8_SA(1, 1), a1 + hstepA, voffA);
            PG8_WAIT_V(8); PG8_WAIT_L(0); PG8_BAR; PG8_MMA(0, 0, At, B0); PG8_MMA(0, 1, At, B1); PG8_BAR; PG8_SCHED;
            PG8_LDA(At, 0, 1); PG8_STAGE(PG8_SB(0, 0), b2, voffB); PG8_STAGE(PG8_SB(0, 1), b2 + hstepB, voffB); PG8_STAGE(PG8_SA(0, 0), a2, voffA);
            PG8_WAIT_V(8); PG8_WAIT_L(0); PG8_BAR; PG8_MMA(1, 0, At, B0); PG8_MMA(1, 1, At, B1); PG8_BAR; PG8_SCHED;
            PG8_LDB(B0, 1, 0); PG8_LDB(B1, 1, 1); PG8_SCHED; PG8_LDA(At, 1, 0); PG8_STAGE(PG8_SA(0, 1), a2 + hstepA, voffA);
            PG8_WAIT_V(8); PG8_WAIT_L(0); PG8_BAR; PG8_MMA(0, 0, At, B0); PG8_MMA(0, 1, At, B1); PG8_BAR; PG8_SCHED;
            PG8_LDA(At, 1, 1); PG8_STAGE(PG8_SB(1, 0), b3, voffB); PG8_STAGE(PG8_SB(1, 1), b3 + hstepB, voffB); PG8_STAGE(PG8_SA(1, 0), a3, voffA);
            PG8_WAIT_V(8); PG8_WAIT_L(0); PG8_BAR; PG8_MMA(1, 0, At, B0); PG8_MMA(1, 1, At, B1); PG8_BAR; PG8_SCHED;
        }
        if constexpr (ALIGN_EPI) { if (wr == 0) PG8_BAR; }
        if constexpr (F8) {
            asm volatile("s_nop 15\n\ts_nop 15" : "+v"(acc[0][0][0][0]), "+v"(acc[0][0][0][1]), "+v"(acc[0][0][1][0]), "+v"(acc[0][0][1][1]), "+v"(acc[0][0][2][0]), "+v"(acc[0][0][2][1]), "+v"(acc[0][0][3][0]), "+v"(acc[0][0][3][1]),
                         "+v"(acc[0][1][0][0]), "+v"(acc[0][1][0][1]), "+v"(acc[0][1][1][0]), "+v"(acc[0][1][1][1]), "+v"(acc[0][1][2][0]), "+v"(acc[0][1][2][1]), "+v"(acc[0][1][3][0]), "+v"(acc[0][1][3][1]));
            asm volatile("" : "+v"(acc[1][0][0][0]), "+v"(acc[1][0][0][1]), "+v"(acc[1][0][1][0]), "+v"(acc[1][0][1][1]), "+v"(acc[1][0][2][0]), "+v"(acc[1][0][2][1]), "+v"(acc[1][0][3][0]), "+v"(acc[1][0][3][1]),
                         "+v"(acc[1][1][0][0]), "+v"(acc[1][1][0][1]), "+v"(acc[1][1][1][0]), "+v"(acc[1][1][1][1]), "+v"(acc[1][1][2][0]), "+v"(acc[1][1][2][1]), "+v"(acc[1][1][3][0]), "+v"(acc[1][1][3][1]));
        }
        E(acc, cur, wr, wc, fr, fq);
        if (!has_next) break;
#pragma unroll
        for (int a = 0; a < 2; ++a)
#pragma unroll
            for (int b = 0; b < 2; ++b)
#pragma unroll
                for (int m = 0; m < 4; ++m)
#pragma unroll
                    for (int n = 0; n < 2; ++n) acc[a][b][m][n] = (f32x4){0.f, 0.f, 0.f, 0.f};
        cur = nxt; cA = nA; cB = nB; ++ui;
        if constexpr (ALIGN_EPI) { if (wr == 1) PG8_BAR; }
    }
    PG8_WAIT_V(0);
    if constexpr (!ALIGN_EPI) { if (wr == 0) PG8_BAR; }
    PG8_BAR;
#undef PG8_SA
#undef PG8_SB
#undef PG8_STAGE
#undef PG8_LDA
#undef PG8_LDB
#undef PG8_MMA
#undef PG8_F8FRAG
#undef PG8_WAIT_V
#undef PG8_WAIT_L
#undef PG8_BAR
#undef PG8_SCHED
}
}

constexpr int D = 2048, SEQ = 16384, CTXL = 256, MALL = SEQ + CTXL, DFF = 5632, NMOD = 9 * D;
constexpr int HH = 16, HK = 128, NSEG = 16, SEGLEN = SEQ / NSEG, CHUNK = 64;
constexpr float LN_EPS = 1e-5f, RMS_EPS = 1e-6f, ALPHA = 1.4142135623730951f;
constexpr int NWAVES = 8, NTHREADS = 512;

constexpr size_t MiB = 1u << 20;
constexpr size_t WS_CTL = 0, CTL_ZERO_BYTES = 2 * MiB;
constexpr size_t WS_MOD = 1 * MiB;
constexpr size_t WS_VEC = 2 * MiB;
constexpr size_t WS_RS = 3 * MiB;
constexpr size_t WS_WPT = 4 * MiB, WS_WHO = 6 * MiB, WS_WHI = 14 * MiB, WS_W2T = 54 * MiB, WS_W1T = 142 * MiB;
constexpr size_t WS_ZA = 318 * MiB, WS_ZB = 448 * MiB, WS_H = 578 * MiB, WS_HID = 643 * MiB;
constexpr size_t WS_Q = 822 * MiB, WS_V = 887 * MiB, WS_OG = 952 * MiB, WS_GF = 1017 * MiB, WS_GB = 1082 * MiB;
constexpr size_t WS_ST = 1147 * MiB;
constexpr size_t WS_CST = 1179 * MiB;
constexpr size_t WS_DT = 1181 * MiB;
constexpr size_t WS_SLAB = 1182 * MiB;
constexpr size_t WS_END = 1240 * MiB;
constexpr int NSPLIT = 11;
constexpr int MOD1_CUT = 48 * 2048;
#ifndef MK_F8_IN
#define MK_F8_IN 1
#endif
#ifndef MK_F8_OUT
#define MK_F8_OUT 1
#endif
constexpr bool F8_IN = MK_F8_IN, F8_OUT = MK_F8_OUT;
constexpr float COMB_SCALE = F8_OUT ? (0.5f / 2048.0f) : 0.5f;
constexpr size_t WS_H8 = 1204 * MiB;
#undef WS_END_PLACEHOLDER
constexpr size_t W1T_STRIDE = (size_t)2 * DFF * D, W2T_STRIDE = (size_t)D * DFF;
constexpr int CW_BAR = 4096;

constexpr int RING_OFF = 0, RING_BYTES = 131072;
constexpr int SVEC_OFF = RING_BYTES;
constexpr int MISC_OFF = SVEC_OFF + 16384;
constexpr int LDS_BYTES = MISC_OFF + 1024;

#define GAS __attribute__((address_space(1)))
#define LAS __attribute__((address_space(3)))
typedef unsigned short bf16;
typedef unsigned v4u __attribute__((ext_vector_type(4)));
typedef unsigned v2u __attribute__((ext_vector_type(2)));
typedef float f32x4 __attribute__((ext_vector_type(4)));
typedef float f32x2 __attribute__((ext_vector_type(2)));
typedef short bf16x8 __attribute__((ext_vector_type(8)));
typedef short bf16x4 __attribute__((ext_vector_type(4)));
typedef GAS unsigned gu32;
#define LDS_WAIT() asm volatile("s_waitcnt lgkmcnt(0)" ::: "memory")
#define VM_WAIT() asm volatile("s_waitcnt vmcnt(0)" ::: "memory")
__device__ __forceinline__ unsigned f2bf(float f) { unsigned u = __builtin_bit_cast(unsigned, f); return (u + 0x7fffu + ((u >> 16) & 1u)) >> 16; }
__device__ __forceinline__ unsigned pk2(float lo, float hi) { return pg8::cvt_pk_bf16(lo, hi); }
__device__ __forceinline__ float bf2f(unsigned short b) { return __builtin_bit_cast(float, ((unsigned)b) << 16); }
__device__ __forceinline__ float fexp(float x) { return __builtin_amdgcn_exp2f(1.4426950408889634f * x); }

#define XB_TMO      128
#define XB_XCNT(j)  (256  + 64 * (j))
#define XB_XSUB(j)  (1280 + 64 * (j))
#define XB_XGEN(j)  (2304 + 64 * (j))
#define XB_TOP      3328
#define XB_TOPGEN   3392
#define XCD_BAR_WORDS 3456
#define XB_SPIN_CAP (1u << 18)
__device__ __forceinline__ unsigned xb_ld(unsigned* p)              { return __hip_atomic_load(p, __ATOMIC_RELAXED, __HIP_MEMORY_SCOPE_AGENT); }
__device__ __forceinline__ unsigned xb_add(unsigned* p, unsigned v) { return __hip_atomic_fetch_add(p, v, __ATOMIC_RELAXED, __HIP_MEMORY_SCOPE_AGENT); }
__device__ __forceinline__ unsigned xb_xcc_id() { return (unsigned)__builtin_amdgcn_s_getreg((3 << 11) | 20) & 0xFu; }
#define XB_SPIN(cond, bar) do { unsigned _sp = 0; while (cond) { __builtin_amdgcn_s_sleep(1); \
    if ((++_sp & 255u) == 0u) { if (xb_ld(&(bar)[XB_TMO])) break; if (_sp > XB_SPIN_CAP) { atomicAdd(&(bar)[XB_TMO], 1u); break; } } } } while (0)
struct XcdBarrier { unsigned* bar; unsigned x; volatile LAS unsigned* st; };
__device__ __forceinline__ XcdBarrier xcd_barrier_post(unsigned* bar, volatile LAS unsigned* st) {
    XcdBarrier b; b.bar = bar; b.x = xb_xcc_id(); b.st = st;
    if (threadIdx.x == 0) (void)xb_add(&bar[XB_XCNT(b.x)], 1u);
    return b;
}
__device__ __forceinline__ void xcd_barrier_complete(unsigned* bar, unsigned x, unsigned& nloc, unsigned& nx) {
    const unsigned G = gridDim.x * gridDim.y * gridDim.z;
    unsigned sum, cnt, mine, sp = 0u;
    for (;;) {
        sum = 0u; cnt = 0u; mine = 0u;
#pragma unroll
        for (unsigned j = 0; j < 16; ++j) { const unsigned c = xb_ld(&bar[XB_XCNT(j)]); sum += c; cnt += (c > 0u) ? 1u : 0u; mine = (j == x) ? c : mine; }
        if (sum == G) break;
        __builtin_amdgcn_s_sleep(1);
        if ((++sp & 255u) == 0u) { if (xb_ld(&bar[XB_TMO])) break; if (sp > XB_SPIN_CAP) { atomicAdd(&bar[XB_TMO], 1u); break; } }
    }
    nloc = mine > 0u ? mine : 1u; nx = cnt > 0u ? cnt : 1u;
}
__device__ __forceinline__ void xcd_barrier(const XcdBarrier& b) {
    asm volatile("s_waitcnt vmcnt(0)" ::: "memory");
    __syncthreads();
    if (threadIdx.x == 0) {
        unsigned* bar = b.bar;
        __builtin_amdgcn_s_waitcnt(0);
        unsigned nloc = b.st[0], nx = b.st[1];
        if (nloc == 0u) { xcd_barrier_complete(bar, b.x, nloc, nx); b.st[0] = nloc; b.st[1] = nx; }
        const unsigned old = xb_add(&bar[XB_XSUB(b.x)], 1u);
        const unsigned gen = old / nloc;
        if (old + 1u == (gen + 1u) * nloc) {
            __builtin_amdgcn_fence(__ATOMIC_RELEASE, "agent");
            asm volatile("s_waitcnt vmcnt(0)" ::: "memory");
            const unsigned og = xb_add(&bar[XB_TOP], 1u);
            const unsigned tg = og / nx;
            if (og + 1u == (tg + 1u) * nx) xb_add(&bar[XB_TOPGEN], 1u);
            else XB_SPIN(xb_ld(&bar[XB_TOPGEN]) == tg, bar);
            __builtin_amdgcn_fence(__ATOMIC_ACQUIRE, "agent");
            xb_add(&bar[XB_XGEN(b.x)], 1u);
            asm volatile("s_waitcnt vmcnt(0)" ::: "memory");
        } else {
            XB_SPIN(xb_ld(&bar[XB_XGEN(b.x)]) == gen, bar);
            __builtin_amdgcn_fence(__ATOMIC_ACQUIRE, "agent");
            asm volatile("s_waitcnt vmcnt(0)" ::: "memory");
        }
    }
    __syncthreads();
}

struct Frame {
    LAS unsigned char* lds;
    int tid, lane, wave, G, gw, NGW;
    const float* in[16]; float* out; unsigned char* ws;
};
__device__ __forceinline__ float wave_sum(float v) {
#define WS_ROR(s, n) ((s) + __builtin_bit_cast(float, __builtin_amdgcn_update_dpp(0, __builtin_bit_cast(int, (s)), 0x120 + (n), 0xf, 0xf, false)))
    v = WS_ROR(v, 8); v = WS_ROR(v, 4); v = WS_ROR(v, 2); v = WS_ROR(v, 1);
#undef WS_ROR
    { const unsigned sb = __builtin_bit_cast(unsigned, v); const auto p = __builtin_amdgcn_permlane16_swap(sb, sb, false, false); const unsigned p0 = p[0], p1 = p[1]; v = __builtin_bit_cast(float, p0) + __builtin_bit_cast(float, p1); }
    { const unsigned sb = __builtin_bit_cast(unsigned, v); const auto p = __builtin_amdgcn_permlane32_swap(sb, sb, false, false); const unsigned p0 = p[0], p1 = p[1]; v = __builtin_bit_cast(float, p0) + __builtin_bit_cast(float, p1); }
    return v;
}

__device__ __forceinline__ void p0_transpose_item(const float* W, int K, int N, bf16* WT, int k0, int n0, int drow0, LAS float* scr, int lane) {
#pragma unroll
    for (int i = 0; i < 32; ++i) { const int kk = 2 * i + (lane >> 5); scr[kk * 33 + (lane & 31)] = W[(size_t)(k0 + kk) * N + n0 + (lane & 31)]; }
    LDS_WAIT(); asm volatile("" ::: "memory");
    const int c = lane & 7;
#pragma unroll
    for (int j = 0; j < 4; ++j) { const int n = (lane >> 3) + 8 * j; const LAS float* s = scr + (8 * c) * 33 + n;
        v4u o; o.x = pk2(s[0 * 33], s[1 * 33]); o.y = pk2(s[2 * 33], s[3 * 33]); o.z = pk2(s[4 * 33], s[5 * 33]); o.w = pk2(s[6 * 33], s[7 * 33]);
        *(GAS v4u*)(WT + (size_t)(drow0 + n) * K + k0 + 8 * c) = o; }
    LDS_WAIT(); asm volatile("" ::: "memory");
}
__device__ __forceinline__ void p0_transpose_item8(const float* W, int K, int N, unsigned char* WT, int k0, int n0, int drow0, float scale, LAS float* scr, int lane) {
#pragma unroll
    for (int i = 0; i < 32; ++i) { const int kk = 2 * i + (lane >> 5); scr[kk * 33 + (lane & 31)] = W[(size_t)(k0 + kk) * N + n0 + (lane & 31)]; }
    LDS_WAIT(); asm volatile("" ::: "memory");
    const int n = lane >> 1, hf = lane & 1; const LAS float* sp = scr + (32 * hf) * 33 + n;
    unsigned w[8];
#pragma unroll
    for (int j = 0; j < 8; ++j) w[j] = pg8::cvt4_fp8(sp[(4 * j) * 33] * scale, sp[(4 * j + 1) * 33] * scale, sp[(4 * j + 2) * 33] * scale, sp[(4 * j + 3) * 33] * scale);
    GAS v4u* o = (GAS v4u*)(WT + (size_t)(drow0 + n) * K + k0 + 32 * hf);
    o[0] = (v4u){w[0], w[1], w[2], w[3]}; o[1] = (v4u){w[4], w[5], w[6], w[7]};
    LDS_WAIT(); asm volatile("" ::: "memory");
}
__device__ __forceinline__ void conv_stage(Frame& F, int stage, int wk, int nwk, int part = 0) {
    LAS float* scr = (LAS float*)(F.lds + RING_OFF + F.wave * 16384);
    constexpr int I_W1 = (D / 64) * (2 * DFF / 32), I_W2 = (DFF / 64) * (D / 32), I_HI = (D / 64) * (5 * D / 32), I_HO = (D / 64) * (D / 32), I_WP = (512 / 64) * (512 / 32);
    if (stage == 3) {
        for (int it = (part == 2 ? I_HI : 0) + wk; it < (part == 1 ? I_HI : I_HI + I_HO); it += nwk) {
            int r = it;
            if (r < I_HI) { const int nblk = 5 * D / 32, kb = r / nblk, nb = r % nblk;
                p0_transpose_item(F.in[12], D, 5 * D, (bf16*)(F.ws + WS_WHI), 64 * kb, 32 * nb, 32 * nb, scr, F.lane); continue; }
            r -= I_HI;
            { const int nblk = D / 32, kb = r / nblk, nb = r % nblk;
                p0_transpose_item(F.in[15], D, D, (bf16*)(F.ws + WS_WHO), 64 * kb, 32 * nb, 32 * nb, scr, F.lane); }
        }
        return;
    }
    const int mi = (stage == 0) ? 0 : (stage == 4 ? 3 : stage);
    const int nit = I_W1 + I_W2 + (stage == 0 ? 4 * I_WP : 0);
    for (int it = (part == 2 ? I_W1 : 0) + wk; it < (part == 1 ? I_W1 : nit); it += nwk) {
        int r = it;
        if (r < I_W1) { const int nblk = 2 * DFF / 32, kb = r / nblk, nb = r % nblk, n0 = 32 * nb;
            const int half = (n0 >= DFF) ? 1 : 0, j = n0 - half * DFF, drow0 = 256 * (j / 128) + 128 * half + (j % 128);
            if (F8_IN) p0_transpose_item8(F.in[8] + (size_t)mi * D * 2 * DFF, D, 2 * DFF, (unsigned char*)(F.ws + WS_W1T) + (size_t)mi * W1T_STRIDE * 2, 64 * kb, n0, drow0, 64.0f, scr, F.lane);
            else p0_transpose_item(F.in[8] + (size_t)mi * D * 2 * DFF, D, 2 * DFF, (bf16*)(F.ws + WS_W1T) + (size_t)mi * W1T_STRIDE, 64 * kb, n0, drow0, scr, F.lane);
            continue; }
        r -= I_W1;
        if (r < I_W2) { const int nblk = D / 32, kb = r / nblk, nb = r % nblk;
            if (F8_OUT) p0_transpose_item8(F.in[9] + (size_t)mi * DFF * D, DFF, D, (unsigned char*)(F.ws + WS_W2T) + (size_t)mi * W2T_STRIDE * 2, 64 * kb, 32 * nb, 32 * nb, 128.0f, scr, F.lane);
            else p0_transpose_item(F.in[9] + (size_t)mi * DFF * D, DFF, D, (bf16*)(F.ws + WS_W2T) + (size_t)mi * W2T_STRIDE, 64 * kb, 32 * nb, 32 * nb, scr, F.lane);
            continue; }
        r -= I_W2;
        { const int gi = r / I_WP; r -= gi * I_WP; const int nblk = 512 / 32, kb = r / nblk, nb = r % nblk;
            p0_transpose_item(F.in[10] + (size_t)gi * 512 * 512, 512, 512, (bf16*)(F.ws + WS_WPT) + (size_t)gi * 512 * 512, 64 * kb, 32 * nb, 32 * nb, scr, F.lane); }
    }
}
__device__ __forceinline__ void mod_gemv(Frame& F, const LAS float* sv, int layer0, int lo, int hi, int wk, int nwk) {
    float* mod = (float*)(F.ws + WS_MOD);
    const int total = hi - lo, per = (total + nwk - 1) / nwk;
    int idx = lo + wk * per; const int iend = (idx + per) < hi ? (idx + per) : hi;
    while (idx < iend) {
        const int strip_g = idx / D, k0 = idx % D, layer = layer0 + strip_g / 72, strip = strip_g % 72;
        const int kend = (k0 + (iend - idx)) < D ? (k0 + (iend - idx)) : D;
        const float* W = F.in[4] + (size_t)layer * D * NMOD + strip * 256 + 4 * F.lane;
        f32x4 al = {0.f, 0.f, 0.f, 0.f}, ac = {0.f, 0.f, 0.f, 0.f};
#pragma unroll 8
        for (int k = k0; k < kend; ++k) { const f32x4 w = *(const GAS f32x4*)(W + (size_t)k * NMOD); const float s0 = sv[k], s1 = sv[D + k]; al += w * s0; ac += w * s1; }
        const int col = strip * 256 + 4 * F.lane;
        if (k0 == 0) { const f32x4 b = *(const f32x4*)(F.in[5] + (size_t)layer * NMOD + col); al += b; ac += b; }
        float* ml = mod + (size_t)(layer * 2 + 0) * NMOD + col; float* mc = mod + (size_t)(layer * 2 + 1) * NMOD + col;
#pragma unroll
        for (int j = 0; j < 4; ++j) { atomicAdd(ml + j, al[j]); atomicAdd(mc + j, ac[j]); }
        idx += kend - k0;
    }
}
__device__ __forceinline__ void p0_prologue(Frame& F, const bool do_mod) {
    LAS float* scr = (LAS float*)(F.lds + RING_OFF + F.wave * 16384);
    LAS float* sv = (LAS float*)(F.lds + SVEC_OFF);
    for (int i = F.tid; i < 2 * D; i += NTHREADS) { const float x = (i < D) ? F.in[1][i] : F.in[3][i - D]; sv[i] = pg8::fsilu(x); }
    if (blockIdx.x == 0) { float* vec = (float*)(F.ws + WS_VEC); for (int i = F.tid; i < 2 * D; i += NTHREADS) vec[i] = (i < D) ? 1.0f : 0.0f; }
    __syncthreads();
    const int gw = F.gw, NGW = F.NGW;
    if (do_mod) mod_gemv(F, sv, 0, 0, 72 * D, gw, NGW);
    conv_stage(F, 0, gw, NGW, 1);
}

struct CtxComb { const float* slab; const void* zprev; const float* lgp; const float* lbp; const float* gate; _Float16* zout; };
typedef _Float16 hf16x4 __attribute__((ext_vector_type(4)));
__device__ __forceinline__ f32x4 h4_to_f4(hf16x4 h) { return (f32x4){(float)h[0], (float)h[1], (float)h[2], (float)h[3]}; }
__device__ __forceinline__ hf16x4 f4_to_h4(f32x4 v) { return (hf16x4){(_Float16)v.x, (_Float16)v.y, (_Float16)v.z, (_Float16)v.w}; }
template <int MODE, bool COMB = false, bool F8 = false, bool ZPREV_F32 = false>
__device__ __forceinline__ void t_rows(Frame& F, const void* z_lat, const void* z_ctx, const float* lg, const float* lb, const float* mod_lat, const float* mod_ctx, int sub,
                                       bf16* H, float* outf, float* RS, int nrows, const CtxComb cc = CtxComb{}) {
    const int gw = F.gw, NGW = F.NGW, lane = F.lane;
    {
        const int rhi = nrows < SEQ ? nrows : SEQ;
        const bool xl = (F.G == 256) && (rhi == SEQ);
        const int rstep = xl ? 256 : NGW;
        int r = xl ? (2048 * ((int)blockIdx.x & 7) + ((int)blockIdx.x >> 3) * 8 + F.wave) : gw;
        const int rend = xl ? (2048 * ((int)blockIdx.x & 7) + 2048) : rhi;
        if (r < rend) {
            f32x4 P[8], Q[8];
#pragma unroll
            for (int j = 0; j < 8; ++j) { const int c = 4 * lane + 256 * j;
                f32x4 g = {1.f, 1.f, 1.f, 1.f}, b = {0.f, 0.f, 0.f, 0.f};
                if (MODE != 0) { g = *(const f32x4*)(lg + c); b = *(const f32x4*)(lb + c); }
                if (MODE != 2) { const f32x4 sh = *(const f32x4*)(mod_lat + (size_t)(sub * 3 + 0) * D + c), sc = *(const f32x4*)(mod_lat + (size_t)(sub * 3 + 1) * D + c); P[j] = g * (sc + 1.0f); Q[j] = b * (sc + 1.0f) + sh; }
                else { P[j] = g; Q[j] = b; } }
            f32x4 rawf[MODE == 0 ? 8 : 1]; hf16x4 rawh[MODE == 0 ? 1 : 8];
#define TR_LOAD(row_) do { const size_t zo_ = (size_t)(row_) * D; _Pragma("unroll") for (int j = 0; j < 8; ++j) { \
            if constexpr (MODE == 0) rawf[j] = ((const GAS f32x4*)((const float*)z_lat + zo_) + lane)[64 * j]; else rawh[j] = ((const GAS hf16x4*)((const _Float16*)z_lat + zo_) + lane)[64 * j]; } } while (0)
            TR_LOAD(r);
#pragma unroll 1
            for (; r < rend; r += rstep) {
                f32x4 v[8]; float s = 0.f;
#pragma unroll
                for (int j = 0; j < 8; ++j) { if constexpr (MODE == 0) v[j] = rawf[j]; else v[j] = h4_to_f4(rawh[j]);
                    s += (v[j].x + v[j].y) + (v[j].z + v[j].w); }
                asm volatile("" ::: "memory");
                if (r + rstep < rend) TR_LOAD(r + rstep);
                asm volatile("" ::: "memory");
                float mean = 0.f, rstd = 1.f;
                if (MODE != 0) {
                    mean = wave_sum(s) * (1.f / D); float s2 = 0.f;
#pragma unroll
                    for (int j = 0; j < 8; ++j) { const f32x4 d = v[j] - mean; s2 += (d.x * d.x + d.y * d.y) + (d.z * d.z + d.w * d.w); }
                    rstd = 1.0f / sqrtf(wave_sum(s2) * (1.f / D) + LN_EPS);
                }
                if (MODE != 2 && lane == 0) *(f32x2*)(RS + 2 * (size_t)r) = (f32x2){mean, rstd};
                if (MODE == 2) { GAS f32x4* o = (GAS f32x4*)(outf + (size_t)r * D) + lane;
#pragma unroll
                    for (int j = 0; j < 8; ++j) o[64 * j] = ((v[j] - mean) * rstd) * P[j] + Q[j];
                } else if (F8) { GAS unsigned* o = (GAS unsigned*)((unsigned char*)H + (size_t)r * D) + lane;
#pragma unroll
                    for (int j = 0; j < 8; ++j) { const f32x4 h = ((v[j] - mean) * rstd) * P[j] + Q[j]; o[64 * j] = pg8::cvt4_fp8(h.x, h.y, h.z, h.w); }
                } else { GAS v2u* o = (GAS v2u*)(H + (size_t)r * D) + lane;
#pragma unroll
                    for (int j = 0; j < 8; ++j) { const f32x4 h = ((v[j] - mean) * rstd) * P[j] + Q[j]; v2u w; w.x = pk2(h.x, h.y); w.y = pk2(h.z, h.w); o[64 * j] = w; } }
            }
#undef TR_LOAD
        }
    }
    if (MODE != 2 && nrows > SEQ) {
        LAS float* red = (LAS float*)(F.lds + SVEC_OFF);
        const int c = 256 * F.wave + 4 * lane;
        f32x4 g = {1.f, 1.f, 1.f, 1.f}, b = {0.f, 0.f, 0.f, 0.f};
        if (MODE != 0) { g = *(const f32x4*)(lg + c); b = *(const f32x4*)(lb + c); }
        const f32x4 sh = *(const f32x4*)(mod_ctx + (size_t)(sub * 3 + 0) * D + c), sc = *(const f32x4*)(mod_ctx + (size_t)(sub * 3 + 1) * D + c);
        const f32x4 Pc = g * (sc + 1.0f), Qc = b * (sc + 1.0f) + sh;
#pragma unroll 1
        for (int j = (int)blockIdx.x; j < nrows - SEQ; j += F.G) { const int r = SEQ + j; const size_t ro = (size_t)j * D;
            f32x4 v;
            if (COMB) {
                const f32x2 st0 = *(const f32x2*)(RS + 2 * (size_t)r); f32x4 a = {0.f, 0.f, 0.f, 0.f};
#pragma unroll
                for (int sp = 0; sp < NSPLIT; ++sp) a += *(const GAS f32x4*)(cc.slab + (size_t)sp * CTXL * D + ro + c);
                const f32x4 zp = ZPREV_F32 ? *(const GAS f32x4*)((const float*)cc.zprev + ro + c) : h4_to_f4(*(const GAS hf16x4*)((const _Float16*)cc.zprev + ro + c));
                const f32x4 xp = ((zp - st0.x) * st0.y) * *(const f32x4*)(cc.lgp + c) + *(const f32x4*)(cc.lbp + c);
                const hf16x4 zh = f4_to_h4(xp * ALPHA + (*(const f32x4*)(cc.gate + c) * COMB_SCALE) * a);
                *(GAS hf16x4*)(cc.zout + ro + c) = zh; v = h4_to_f4(zh);
            } else {
                if constexpr (MODE == 0) v = *(const GAS f32x4*)((const float*)z_ctx + ro + c); else v = h4_to_f4(*(const GAS hf16x4*)((const _Float16*)z_ctx + ro + c));
            }
            float mean = 0.f, rstd = 1.f;
            if (MODE != 0) {
                const float s = wave_sum((v.x + v.y) + (v.z + v.w));
                if (lane == 0) red[F.wave] = s;
                __syncthreads();
                { const f32x4 r0 = *(const LAS f32x4*)(red), r1 = *(const LAS f32x4*)(red + 4); mean = (((r0.x + r0.y) + (r0.z + r0.w)) + ((r1.x + r1.y) + (r1.z + r1.w))) * (1.f / D); }
                const f32x4 d = v - mean;
                const float s2 = wave_sum((d.x * d.x + d.y * d.y) + (d.z * d.z + d.w * d.w));
                if (lane == 0) red[8 + F.wave] = s2;
                __syncthreads();
                { const f32x4 r0 = *(const LAS f32x4*)(red + 8), r1 = *(const LAS f32x4*)(red + 12); rstd = 1.0f / sqrtf((((r0.x + r0.y) + (r0.z + r0.w)) + ((r1.x + r1.y) + (r1.z + r1.w))) * (1.f / D) + LN_EPS); }
                __syncthreads();
            }
            if (F.tid == 0) *(f32x2*)(RS + 2 * (size_t)r) = (f32x2){mean, rstd};
            const f32x4 h = ((v - mean) * rstd) * Pc + Qc;
            if (F8) *(GAS unsigned*)((unsigned char*)H + (size_t)r * D + c) = pg8::cvt4_fp8(h.x, h.y, h.z, h.w);
            else { v2u w; w.x = pk2(h.x, h.y); w.y = pk2(h.z, h.w); *(GAS v2u*)(H + (size_t)r * D + c) = w; }
        }
    }
}

__device__ __forceinline__ void unpack8(const v4u w, float (&f)[8]) {
    f[0] = __builtin_bit_cast(float, w.x << 16); f[1] = __builtin_bit_cast(float, w.x & 0xffff0000u); f[2] = __builtin_bit_cast(float, w.y << 16); f[3] = __builtin_bit_cast(float, w.y & 0xffff0000u);
    f[4] = __builtin_bit_cast(float, w.z << 16); f[5] = __builtin_bit_cast(float, w.z & 0xffff0000u); f[6] = __builtin_bit_cast(float, w.w << 16); f[7] = __builtin_bit_cast(float, w.w & 0xffff0000u);
}
template <int HW, int NR>
__device__ __forceinline__ void tp_pool_band(Frame& F, const bf16* H, bf16* PB, int band, int slab) {
    constexpr int VMP = 72, W2 = 2 * HW;
    LAS float* VM = (LAS float*)(F.lds + RING_OFF);
    const int tid = F.tid, c = tid >> 3, oct = tid & 7, R0 = band * NR, ch = slab * 64 + oct * 8;
    const bf16* base = H + (size_t)c * D + ch;
    v4u ring[W2]; float rs[8];
#pragma unroll
    for (int j = 0; j < 8; ++j) rs[j] = 0.f;
#pragma unroll
    for (int k = 0; k < W2; ++k) { const int row = R0 - HW + k; v4u v = {0u, 0u, 0u, 0u}; if (row >= 0 && row < 256) v = *(const GAS v4u*)(base + (size_t)row * 64 * D); ring[(k + HW) % W2] = v; }
    v4u pn = {0u, 0u, 0u, 0u};
    if (R0 + HW < 256) pn = *(const GAS v4u*)(base + (size_t)(R0 + HW) * 64 * D);
#pragma unroll
    for (int k = 0; k < W2; ++k) { float f[8]; unpack8(ring[k], f);
#pragma unroll
        for (int j = 0; j < 8; ++j) rs[j] += f[j]; }
    const int clo = (c - HW) < 0 ? 0 : (c - HW), chi = (c + HW) > 64 ? 64 : (c + HW); const float icc = 1.0f / (float)(chi - clo);
#pragma unroll 1
    for (int ob = 0; ob < NR; ob += W2) {
#pragma unroll
        for (int k = 0; k < W2; ++k) { const int i = ob + k, R = R0 + i; constexpr int dummy_ = 0; (void)dummy_;
            const int es = (k + HW - 1) % W2;
            if (i > 0) { float fn[8], fo[8]; unpack8(pn, fn); unpack8(ring[es], fo);
#pragma unroll
                for (int j = 0; j < 8; ++j) { rs[j] += fn[j]; rs[j] -= fo[j]; }
                ring[es] = pn; }
            asm volatile("" ::: "memory");
            { v4u nx = {0u, 0u, 0u, 0u}; if (i + 1 < NR && R + HW < 256) nx = *(const GAS v4u*)(base + (size_t)(R + HW) * 64 * D); pn = nx; }
            asm volatile("" ::: "memory");
            const int lo = (R - HW) < 0 ? 0 : (R - HW), hi = (R + HW) > 256 ? 256 : (R + HW); const float icr = 1.0f / (float)(hi - lo);
            LAS float* vm = VM + (i & 1) * 64 * VMP;
            *(LAS f32x4*)(vm + c * VMP + oct * 8) = (f32x4){rs[0] * icr, rs[1] * icr, rs[2] * icr, rs[3] * icr};
            *(LAS f32x4*)(vm + c * VMP + oct * 8 + 4) = (f32x4){rs[4] * icr, rs[5] * icr, rs[6] * icr, rs[7] * icr};
            float hc[8]; unpack8(ring[k], hc);
            __syncthreads();
            f32x4 a0 = {0.f, 0.f, 0.f, 0.f}, a1 = {0.f, 0.f, 0.f, 0.f};
            for (int cc = clo; cc < chi; ++cc) { a0 += *(const LAS f32x4*)(vm + cc * VMP + oct * 8); a1 += *(const LAS f32x4*)(vm + cc * VMP + oct * 8 + 4); }
            v4u o; o.x = pk2(a0.x * icc - hc[0], a0.y * icc - hc[1]); o.y = pk2(a0.z * icc - hc[2], a0.w * icc - hc[3]);
            o.z = pk2(a1.x * icc - hc[4], a1.y * icc - hc[5]); o.w = pk2(a1.z * icc - hc[6], a1.w * icc - hc[7]);
            *(GAS v4u*)(PB + (size_t)(R * 64 + c) * D + ch) = o;
        }
    }
    __syncthreads();
}
__device__ __forceinline__ void tp_pool(Frame& F, const bf16* H, bf16* PB) {
    const int tid = F.tid;
#pragma unroll 1
    for (int tile = blockIdx.x; tile < 256; tile += F.G) {
        if (tile < 128) tp_pool_band<8, 16>(F, H, PB, tile >> 3, 24 + (tile & 7));
        else if (tile < 192) tp_pool_band<4, 32>(F, H, PB, (tile - 128) >> 3, 16 + (tile & 7));
        else if (tile < 224) tp_pool_band<2, 64>(F, H, PB, (tile - 192) >> 3, 8 + (tile & 7));
        else tp_pool_band<1, 64>(F, H, PB, (tile - 224) >> 3, tile & 7);
    }
    for (int item = blockIdx.x * NTHREADS + tid; item < CTXL * 256; item += F.G * NTHREADS) {
        const int t = item >> 8, o8 = item & 255, ch = o8 * 8, grp = ch >> 9, w = 2 << grp, hw = w >> 1;
        const int lo = (t - hw) < 0 ? 0 : (t - hw), hi = (t + hw) > CTXL ? CTXL : (t + hw);
        float a[8];
#pragma unroll
        for (int j = 0; j < 8; ++j) a[j] = 0.f;
        v4u wr[16];
#pragma unroll
        for (int q = 0; q < 16; ++q) { v4u x = {0u, 0u, 0u, 0u}; if (lo + q < hi) x = *(const GAS v4u*)(H + (size_t)(SEQ + lo + q) * D + ch); wr[q] = x; }
#pragma unroll
        for (int q = 0; q < 16; ++q) { float f[8]; unpack8(wr[q], f);
#pragma unroll
            for (int j = 0; j < 8; ++j) a[j] += f[j]; }
        float hc[8]; unpack8(*(const GAS v4u*)(H + (size_t)(SEQ + t) * D + ch), hc); const float ic = 1.0f / (float)(hi - lo);
        v4u o; o.x = pk2(a[0] * ic - hc[0], a[1] * ic - hc[1]); o.y = pk2(a[2] * ic - hc[2], a[3] * ic - hc[3]); o.z = pk2(a[4] * ic - hc[4], a[5] * ic - hc[5]); o.w = pk2(a[6] * ic - hc[6], a[7] * ic - hc[7]);
        *(GAS v4u*)(PB + (size_t)(SEQ + t) * D + ch) = o;
    }
}

#define MK_RSRC(p, bytes) __builtin_amdgcn_make_buffer_rsrc((void*)(p), 0, (int)(bytes), 0x00020000)
#define BLD32(rs, vo, so) ((unsigned)__builtin_amdgcn_raw_buffer_load_b32((rs), (int)(vo), (int)(so), 0))
#define BLD16(rs, vo, so) ((unsigned short)__builtin_amdgcn_raw_buffer_load_b16((rs), (int)(vo), (int)(so), 0))
#define BST32(rs, x, vo, so) __builtin_amdgcn_raw_buffer_store_b32((unsigned)(x), (rs), (int)(vo), (int)(so), 0)
#define BST16(rs, x, vo, so) __builtin_amdgcn_raw_buffer_store_b16((unsigned short)(x), (rs), (int)(vo), (int)(so), 0)
#define BLD64(rs, vo, so) (__builtin_amdgcn_raw_buffer_load_b64((rs), (int)(vo), (int)(so), 0))
#define BST64(rs, x, vo, so) __builtin_amdgcn_raw_buffer_store_b64((x), (rs), (int)(vo), (int)(so), 0)
constexpr int SC_QT = 0, SC_KT = 17408, SC_KTT = 34816, SC_VT = 53248, SC_AT = 71680, SC_QTOT = 80896, SC_FAC = 84992, SC_SSQ = 85504, SC_END = 87552;
struct ScanT { const bf16* Q; const bf16* V; const unsigned short* G0; const unsigned short* G1; const bf16* OG; float* OF; bf16* YG; float* ST; float* CST; float* DT; const float* normg; };

template <bool PHC>
__device__ __forceinline__ void scan_unit(Frame& F, const ScanT& T, int h, int dir, int tfirst, int cstride, int nch, const float* st_in, float* st_out, float* dt_out) {
    LAS unsigned char* L = F.lds + RING_OFF;
    const int lane = F.lane, w = F.wave, l15 = lane & 15, h4 = lane >> 4;
    const int cp = lane, tg = w;
    constexpr unsigned A2B = (unsigned)MALL * D * 2u, A4B = (unsigned)SEQ * D * 4u;
    const __amdgpu_buffer_rsrc_t rsG = MK_RSRC(dir ? T.G1 : T.G0, A2B), rsV = MK_RSRC(T.V, A2B), rsQ = MK_RSRC(T.Q, A2B), rsOG = MK_RSRC(T.OG, A2B), rsYG = MK_RSRC(T.YG, A2B), rsOF = MK_RSRC(T.OF, A2B);
    const unsigned coffb = (unsigned)(h * HK + 2 * cp) * 2u;
    f32x4 R[8];
    if (PHC) {
#pragma unroll
        for (int t = 0; t < 8; ++t)
#pragma unroll
            for (int r = 0; r < 4; ++r) R[t][r] = st_in[w * 2048 + (t * 4 + r) * 64 + lane];
    } else {
#pragma unroll
        for (int t = 0; t < 8; ++t) R[t] = (f32x4){0.f, 0.f, 0.f, 0.f};
    }
    float cprev0 = 1.f, cprev1 = 1.f;
    unsigned gr[8], qr[8], vr[8];
#define SC_LOAD(cidx) do { const int _b = tfirst + (cidx) * cstride; _Pragma("unroll") for (int i = 0; i < 8; ++i) { const int tau = 8 * tg + i; const int tok = dir ? (_b + 63 - tau) : (_b + tau); \
        const unsigned so = (unsigned)tok * 4096u; gr[i] = BLD32(rsG, coffb, so); vr[i] = BLD32(rsV, coffb, so); if (PHC) qr[i] = BLD32(rsQ, coffb, so); } } while (0)
#define SC_H2F(x) ((float)__builtin_bit_cast(_Float16, (unsigned short)(x)))
#define SC_BAR() do { asm volatile("s_waitcnt lgkmcnt(0)" ::: "memory"); __builtin_amdgcn_s_barrier(); asm volatile("" ::: "memory"); } while (0)
#define SC_CLAMP(x, lim) ((x) > (lim) ? (lim) : ((x) < -(lim) ? -(lim) : (x)))
#define SC_MFMA(a, b, c) __builtin_amdgcn_mfma_f32_16x16x32_bf16((a), (b), (c), 0, 0, 0)
#define SC_ROR_ADD(s, n) ((s) + __builtin_bit_cast(float, __builtin_amdgcn_update_dpp(0, __builtin_bit_cast(int, (s)), 0x120 + (n), 0xf, 0xf, false)))
    SC_LOAD(0);
#pragma unroll 1
    for (int c = 0; c < nch; ++c) {
        const int tbase = tfirst + c * cstride;
        float f0[8], f1[8], kq0[8], kq1[8]; float run0 = 1.f, run1 = 1.f;
#pragma unroll
        for (int i = 0; i < 8; ++i) { kq0[i] = SC_H2F(gr[i] & 0xffffu); kq1[i] = SC_H2F(gr[i] >> 16); f0[i] = 1.0f - kq0[i]; f1[i] = 1.0f - kq1[i]; run0 *= f0[i]; run1 *= f1[i]; }
        *(LAS f32x2*)(L + SC_QTOT + (tg * 128 + 2 * cp) * 4) = (f32x2){run0, run1};
        SC_BAR();
        float num0 = 1.f, num1 = 1.f, den0 = 1.f, den1 = 1.f, lo0 = 1.f, lo1 = 1.f, hi0 = 1.f, hi1 = 1.f;
#pragma unroll
        for (int g = 0; g < 8; ++g) { const f32x2 t = *(const LAS f32x2*)(L + SC_QTOT + (g * 128 + 2 * cp) * 4);
            if (g < 4) { lo0 *= t.x; lo1 *= t.y; if (g >= tg) { den0 *= t.x; den1 *= t.y; } } else { hi0 *= t.x; hi1 *= t.y; if (g < tg) { num0 *= t.x; num1 *= t.y; } } }
        float e0 = num0 * __builtin_amdgcn_rcpf(fmaxf(den0, 1e-30f)), e1 = num1 * __builtin_amdgcn_rcpf(fmaxf(den1, 1e-30f));
        unsigned kc0[4], kc1[4], vc0[4], vc1[4]; float kp0 = 0.f, kp1 = 0.f;
#pragma unroll
        for (int i = 0; i < 8; ++i) {
            const int tau = 8 * tg + i;
            e0 *= f0[i]; e1 *= f1[i];
            const float k0 = kq0[i] * __builtin_amdgcn_rcpf(fmaxf(e0, 1e-30f)), k1 = kq1[i] * __builtin_amdgcn_rcpf(fmaxf(e1, 1e-30f));
            *(LAS unsigned*)(L + SC_KT + tau * 272 + cp * 4) = pg8::cvt_pk_bf16(k0, k1);
            if (PHC) { const float q0 = __builtin_bit_cast(float, qr[i] << 16) * e0, q1 = __builtin_bit_cast(float, qr[i] & 0xffff0000u) * e1;
                *(LAS unsigned*)(L + SC_QT + tau * 272 + cp * 4) = pg8::cvt_pk_bf16(q0, q1); }
            if (i & 1) { kc0[i >> 1] = pg8::cvt_pk_bf16(kp0, k0); kc1[i >> 1] = pg8::cvt_pk_bf16(kp1, k1);
                vc0[i >> 1] = __builtin_amdgcn_perm(vr[i], vr[i - 1], 0x05040100u); vc1[i >> 1] = __builtin_amdgcn_perm(vr[i], vr[i - 1], 0x07060302u); }
            else { kp0 = k0; kp1 = k1; }
        }
        *(LAS v4u*)(L + SC_KTT + (2 * cp) * 144 + tg * 16) = (v4u){kc0[0], kc0[1], kc0[2], kc0[3]}; *(LAS v4u*)(L + SC_KTT + (2 * cp + 1) * 144 + tg * 16) = (v4u){kc1[0], kc1[1], kc1[2], kc1[3]};
        *(LAS v4u*)(L + SC_VT + (2 * cp) * 144 + tg * 16) = (v4u){vc0[0], vc0[1], vc0[2], vc0[3]}; *(LAS v4u*)(L + SC_VT + (2 * cp + 1) * 144 + tg * 16) = (v4u){vc1[0], vc1[1], vc1[2], vc1[3]};
        if (tg == 0) { *(LAS f32x2*)(L + SC_FAC + (2 * cp) * 4) = (f32x2){lo0 * cprev0, lo1 * cprev1}; cprev0 = hi0; cprev1 = hi1; }
        if (c + 1 < nch) SC_LOAD(c + 1);
        SC_BAR();
        const unsigned ocolb = (unsigned)(h * HK + 16 * w + 4 * h4) * 2u, orowb = (unsigned)(dir ? (15 - l15) : l15) * 4096u;
        v2u ofv[4]; v2u ogv[4];
        if (PHC && dir) {
#pragma unroll
            for (int tt = 0; tt < 4; ++tt) ofv[tt] = BLD64(rsOF, orowb + ocolb, (unsigned)(tbase + 48 - 16 * tt) * 4096u);
        }
#pragma unroll
        for (int t = 0; t < 8; ++t) { const f32x4 f = *(const LAS f32x4*)(L + SC_FAC + (16 * t + 4 * h4) * 4); R[t] = R[t] * f; }
        if (PHC) {
            const int tt = w >> 1, st0 = 2 * (w & 1);
            bf16x8 qb[4], ka[2][4];
#pragma unroll
            for (int ks = 0; ks < 4; ++ks) { qb[ks] = *(const LAS bf16x8*)(L + SC_QT + (16 * tt + l15) * 272 + (32 * ks + 8 * h4) * 2);
#pragma unroll
                for (int q = 0; q < 2; ++q) ka[q][ks] = *(const LAS bf16x8*)(L + SC_KT + (16 * (st0 + q) + l15) * 272 + (32 * ks + 8 * h4) * 2); }
#pragma unroll
            for (int q = 0; q < 2; ++q) { const int st = st0 + q; f32x4 a = {0.f, 0.f, 0.f, 0.f};
                if (st <= tt) {
#pragma unroll
                    for (int ks = 0; ks < 4; ++ks) a = SC_MFMA(ka[q][ks], qb[ks], a);
                    if (st == tt) {
#pragma unroll
                        for (int r = 0; r < 4; ++r) if (4 * h4 + r > l15) a[r] = 0.f; }
                }
                v2u o; o.x = pg8::cvt_pk_bf16(a[0], a[1]); o.y = pg8::cvt_pk_bf16(a[2], a[3]);
                *(LAS v2u*)(L + SC_AT + (16 * tt + l15) * 144 + (16 * st + 4 * h4) * 2) = o; }
            SC_BAR();
        }
        bf16x8 vb[2];
#pragma unroll
        for (int ss = 0; ss < 2; ++ss) vb[ss] = *(const LAS bf16x8*)(L + SC_VT + (16 * w + l15) * 144 + (32 * ss + 8 * h4) * 2);
        f32x4 O[4];
        if (PHC) {
            bf16x8 rb[4];
#pragma unroll
            for (int ks = 0; ks < 4; ++ks) { v4u p; p.x = pg8::cvt_pk_bf16(R[2 * ks][0], R[2 * ks][1]); p.y = pg8::cvt_pk_bf16(R[2 * ks][2], R[2 * ks][3]); p.z = pg8::cvt_pk_bf16(R[2 * ks + 1][0], R[2 * ks + 1][1]); p.w = pg8::cvt_pk_bf16(R[2 * ks + 1][2], R[2 * ks + 1][3]); rb[ks] = __builtin_bit_cast(bf16x8, p); }
#pragma unroll
            for (int hf = 0; hf < 2; ++hf) {
                v2u qa[2][4][2]; bf16x8 aa[2][2];
#pragma unroll
                for (int t2 = 0; t2 < 2; ++t2) { const int tt = 2 * hf + t2;
#pragma unroll
                    for (int ks = 0; ks < 4; ++ks) { qa[t2][ks][0] = *(const LAS v2u*)(L + SC_QT + (16 * tt + l15) * 272 + (32 * ks + 4 * h4) * 2); qa[t2][ks][1] = *(const LAS v2u*)(L + SC_QT + (16 * tt + l15) * 272 + (32 * ks + 16 + 4 * h4) * 2); }
#pragma unroll
                    for (int ss = 0; ss <= hf; ++ss) aa[t2][ss] = *(const LAS bf16x8*)(L + SC_AT + (16 * tt + l15) * 144 + (32 * ss + 8 * h4) * 2); }
                __builtin_amdgcn_sched_barrier(0);
#pragma unroll
                for (int t2 = 0; t2 < 2; ++t2) { f32x4 o = {0.f, 0.f, 0.f, 0.f};
#pragma unroll
                    for (int ks = 0; ks < 4; ++ks) { const v4u av = {qa[t2][ks][0].x, qa[t2][ks][0].y, qa[t2][ks][1].x, qa[t2][ks][1].y}; o = SC_MFMA(rb[ks], __builtin_bit_cast(bf16x8, av), o); }
#pragma unroll
                    for (int ss = 0; ss <= hf; ++ss) o = SC_MFMA(vb[ss], aa[t2][ss], o);
                    O[2 * hf + t2] = o; }
            }
        }
#pragma unroll
        for (int gq = 0; gq < 2; ++gq) {
            bf16x8 kk[4][2];
#pragma unroll
            for (int t = 0; t < 4; ++t)
#pragma unroll
                for (int ss = 0; ss < 2; ++ss) kk[t][ss] = *(const LAS bf16x8*)(L + SC_KTT + (16 * (4 * gq + t) + l15) * 144 + (32 * ss + 8 * h4) * 2);
            __builtin_amdgcn_sched_barrier(0);
#pragma unroll
            for (int t = 0; t < 4; ++t)
#pragma unroll
                for (int ss = 0; ss < 2; ++ss) R[4 * gq + t] = SC_MFMA(kk[t][ss], vb[ss], R[4 * gq + t]);
        }
        if (PHC) {
            typedef _Float16 h2_t __attribute__((ext_vector_type(2)));
            if (dir == 0) {
#pragma unroll
                for (int tt = 0; tt < 4; ++tt) { const h2_t a = {(_Float16)O[tt][0], (_Float16)O[tt][1]}, b = {(_Float16)O[tt][2], (_Float16)O[tt][3]};
                    const unsigned wa = __builtin_bit_cast(unsigned, a), wb = __builtin_bit_cast(unsigned, b); const v2u wv = {wa, wb};
                    BST64(rsOF, wv, orowb + ocolb, (unsigned)(tbase + 16 * tt) * 4096u); }
            } else {
#pragma unroll
                for (int tt = 0; tt < 4; ++tt) ogv[tt] = BLD64(rsOG, orowb + ocolb, (unsigned)(tbase + 48 - 16 * tt) * 4096u);
                float tot[16];
#pragma unroll
                for (int tt = 0; tt < 4; ++tt) {
                    const unsigned ofx = ofv[tt].x, ofy = ofv[tt].y; const h2_t f01 = __builtin_bit_cast(h2_t, ofx), f23 = __builtin_bit_cast(h2_t, ofy);
                    const float x0 = O[tt][0] + (float)f01[0], x1 = O[tt][1] + (float)f01[1], x2 = O[tt][2] + (float)f23[0], x3 = O[tt][3] + (float)f23[1];
                    tot[tt * 4 + 0] = x0; tot[tt * 4 + 1] = x1; tot[tt * 4 + 2] = x2; tot[tt * 4 + 3] = x3;
                    float sq = (x0 * x0 + x1 * x1) + (x2 * x2 + x3 * x3);
                    { const unsigned sb = __builtin_bit_cast(unsigned, sq); const auto p = __builtin_amdgcn_permlane16_swap(sb, sb, false, false); const unsigned p0 = p[0], p1 = p[1]; sq = __builtin_bit_cast(float, p0) + __builtin_bit_cast(float, p1); }
                    { const unsigned sb = __builtin_bit_cast(unsigned, sq); const auto p = __builtin_amdgcn_permlane32_swap(sb, sb, false, false); const unsigned p0 = p[0], p1 = p[1]; sq = __builtin_bit_cast(float, p0) + __builtin_bit_cast(float, p1); }
                    if (h4 == 0) ((LAS float*)(L + SC_SSQ))[(16 * tt + l15) * 8 + w] = sq; }
                SC_BAR();
                const f32x4 ng = *(const f32x4*)(T.normg + 16 * w + 4 * h4);
#pragma unroll
                for (int tt = 0; tt < 4; ++tt) { const int tau = 16 * tt + l15;
                    const f32x4 s0 = *(const LAS f32x4*)(L + SC_SSQ + tau * 32), s1 = *(const LAS f32x4*)(L + SC_SSQ + tau * 32 + 16);
                    const float ss = ((s0.x + s0.y) + (s0.z + s0.w)) + ((s1.x + s1.y) + (s1.z + s1.w));
                    const float rstd = __builtin_amdgcn_rsqf(ss * (1.0f / 128.0f) + RMS_EPS);
                    const unsigned ogx = ogv[tt].x, ogy = ogv[tt].y; const unsigned gb0 = ogx << 16, gb1 = ogx & 0xffff0000u, gb2 = ogy << 16, gb3 = ogy & 0xffff0000u;
                    const float g0 = __builtin_bit_cast(float, gb0), g1 = __builtin_bit_cast(float, gb1), g2 = __builtin_bit_cast(float, gb2), g3 = __builtin_bit_cast(float, gb3);
                    const v2u wv = {pg8::cvt_pk_bf16(tot[tt * 4 + 0] * rstd * ng[0] * g0, tot[tt * 4 + 1] * rstd * ng[1] * g1), pg8::cvt_pk_bf16(tot[tt * 4 + 2] * rstd * ng[2] * g2, tot[tt * 4 + 3] * rstd * ng[3] * g3)};
                    BST64(rsYG, wv, orowb + ocolb, (unsigned)(tbase + 48 - 16 * tt) * 4096u); }
            }
        }
    }
    static_assert(PHC, "the state-only pass is scan_state_unit");
    SC_BAR();
#undef SC_LOAD
#undef SC_H2F
#undef SC_CLAMP
#undef SC_BAR
#undef SC_MFMA
#undef SC_ROR_ADD
}

__device__ __forceinline__ void scan_state_unit(Frame& F, const ScanT& T, int h, int dir, int tfirst, int cstride, int nch, float* st_out, float* dt_out) {
    LAS unsigned char* L = F.lds + RING_OFF;
    const int lane = F.lane, w = F.wave, l15 = lane & 15, h4 = lane >> 4;
    const int cp = lane, tg = w;
    constexpr unsigned A2B = (unsigned)MALL * D * 2u;
    const __amdgpu_buffer_rsrc_t rsG = MK_RSRC(dir ? T.G1 : T.G0, A2B), rsV = MK_RSRC(T.V, A2B);
    const unsigned coffb = (unsigned)(h * HK + 2 * cp) * 2u;
    f32x4 R[8];
#pragma unroll
    for (int t = 0; t < 8; ++t) R[t] = (f32x4){0.f, 0.f, 0.f, 0.f};
    float dtot0 = 1.f, dtot1 = 1.f;
    unsigned gr[8], vr[8];
#define SA_LOAD(cidx) do { const int _b = tfirst + (cidx) * cstride; _Pragma("unroll") for (int i = 0; i < 8; ++i) { const int tau = 8 * tg + i; const int tok = dir ? (_b + 63 - tau) : (_b + tau); \
        const unsigned so = (unsigned)tok * 4096u; gr[i] = BLD32(rsG, coffb, so); vr[i] = BLD32(rsV, coffb, so); } } while (0)
#define SA_H2F(x) ((float)__builtin_bit_cast(_Float16, (unsigned short)(x)))
#define SA_BAR() do { asm volatile("s_waitcnt lgkmcnt(0)" ::: "memory"); __builtin_amdgcn_s_barrier(); asm volatile("" ::: "memory"); } while (0)
    SA_LOAD(0);
#pragma unroll 1
    for (int c = 0; c < nch; ++c) {
        float k0[8], k1[8]; float gp0 = 1.f, gp1 = 1.f;
#pragma unroll
        for (int i = 0; i < 8; ++i) { k0[i] = SA_H2F(gr[i] & 0xffffu); k1[i] = SA_H2F(gr[i] >> 16); gp0 *= 1.0f - k0[i]; gp1 *= 1.0f - k1[i]; }
        *(LAS f32x2*)(L + SC_QTOT + (tg * 128 + 2 * cp) * 4) = (f32x2){gp0, gp1};
        unsigned vc0[4], vc1[4];
#pragma unroll
        for (int i = 1; i < 8; i += 2) { vc0[i >> 1] = __builtin_amdgcn_perm(vr[i], vr[i - 1], 0x05040100u); vc1[i >> 1] = __builtin_amdgcn_perm(vr[i], vr[i - 1], 0x07060302u); }
        SA_BAR();
        *(LAS v4u*)(L + SC_VT + (2 * cp) * 144 + tg * 16) = (v4u){vc0[0], vc0[1], vc0[2], vc0[3]}; *(LAS v4u*)(L + SC_VT + (2 * cp + 1) * 144 + tg * 16) = (v4u){vc1[0], vc1[1], vc1[2], vc1[3]};
        float sfx0 = 1.f, sfx1 = 1.f, gl0 = 1.f, gl1 = 1.f;
#pragma unroll
        for (int g = 0; g < 8; ++g) { const f32x2 t = *(const LAS f32x2*)(L + SC_QTOT + (g * 128 + 2 * cp) * 4);
            if (g > tg) { sfx0 *= t.x; sfx1 *= t.y; } gl0 *= t.x; gl1 *= t.y; }
        unsigned kc0[4], kc1[4]; float kh0[8], kh1[8];
#pragma unroll
        for (int i = 7; i >= 0; --i) { kh0[i] = k0[i] * sfx0; kh1[i] = k1[i] * sfx1; sfx0 *= 1.0f - k0[i]; sfx1 *= 1.0f - k1[i]; }
#pragma unroll
        for (int i = 0; i < 4; ++i) { kc0[i] = pg8::cvt_pk_bf16(kh0[2 * i], kh0[2 * i + 1]); kc1[i] = pg8::cvt_pk_bf16(kh1[2 * i], kh1[2 * i + 1]); }
        *(LAS v4u*)(L + SC_KTT + (2 * cp) * 144 + tg * 16) = (v4u){kc0[0], kc0[1], kc0[2], kc0[3]}; *(LAS v4u*)(L + SC_KTT + (2 * cp + 1) * 144 + tg * 16) = (v4u){kc1[0], kc1[1], kc1[2], kc1[3]};
        if (tg == 0) { *(LAS f32x2*)(L + SC_FAC + (2 * cp) * 4) = (f32x2){gl0, gl1}; dtot0 *= gl0; dtot1 *= gl1; }
        if (c + 1 < nch) SA_LOAD(c + 1);
        SA_BAR();
#pragma unroll
        for (int t = 0; t < 8; ++t) { const f32x4 f = *(const LAS f32x4*)(L + SC_FAC + (16 * t + 4 * h4) * 4); R[t] = R[t] * f; }
        bf16x8 vb[2];
#pragma unroll
        for (int ss = 0; ss < 2; ++ss) vb[ss] = *(const LAS bf16x8*)(L + SC_VT + (16 * w + l15) * 144 + (32 * ss + 8 * h4) * 2);
#pragma unroll
        for (int gq = 0; gq < 2; ++gq) { bf16x8 kk[4][2];
#pragma unroll
            for (int t = 0; t < 4; ++t)
#pragma unroll
                for (int ss = 0; ss < 2; ++ss) kk[t][ss] = *(const LAS bf16x8*)(L + SC_KTT + (16 * (4 * gq + t) + l15) * 144 + (32 * ss + 8 * h4) * 2);
            __builtin_amdgcn_sched_barrier(0);
#pragma unroll
            for (int t = 0; t < 4; ++t)
#pragma unroll
                for (int ss = 0; ss < 2; ++ss) R[4 * gq + t] = __builtin_amdgcn_mfma_f32_16x16x32_bf16(kk[t][ss], vb[ss], R[4 * gq + t], 0, 0, 0); }
    }
    if (dt_out && tg == 0) *(f32x2*)(dt_out + 2 * cp) = (f32x2){dtot0, dtot1};
#pragma unroll
    for (int t = 0; t < 8; ++t)
#pragma unroll
        for (int r = 0; r < 4; ++r) st_out[w * 2048 + (t * 4 + r) * 64 + lane] = R[t][r];
    SA_BAR();
#undef SA_LOAD
#undef SA_H2F
#undef SA_BAR
}

struct Args { const float* in[16]; float* out; unsigned char* ws; int ph_lo, ph_hi; };
constexpr int NPHASES = 23;

__global__ void __launch_bounds__(NTHREADS, 2) mk_fwd(Args args) {
    extern __shared__ __attribute__((aligned(16))) unsigned char lds[];
    Frame F;
    F.lds = (LAS unsigned char*)lds;
    F.tid = threadIdx.x; F.lane = F.tid & 63; F.wave = __builtin_amdgcn_readfirstlane(F.tid >> 6);
    F.G = gridDim.x; F.gw = blockIdx.x * NWAVES + F.wave; F.NGW = F.G * NWAVES;
#pragma unroll
    for (int i = 0; i < 16; ++i) F.in[i] = args.in[i];
    F.out = args.out; F.ws = args.ws;
    unsigned char* ws = args.ws;
    volatile LAS unsigned* MISC = (volatile LAS unsigned*)(F.lds + MISC_OFF);
    for (int u = F.tid; u < 256; u += NTHREADS) MISC[u] = 0u;
    __syncthreads();
    XcdBarrier bar = xcd_barrier_post((unsigned*)(ws + WS_CTL) + CW_BAR, MISC + 8);
    const int lo = args.ph_lo, hi = args.ph_hi;
#ifndef MK_PHMASK
#define MK_PHMASK 0xffffffffu
#endif
#define IN(k) ((((MK_PHMASK) >> (k)) & 1u) && lo <= (k) && (k) < hi)
#define SEAM(k) do { if (IN(k) && IN((k) + 1)) xcd_barrier(bar); } while (0)
#ifndef MK_DUP
#define MK_DUP 0u
#endif
#define DUPN(k) (1 + (int)(((MK_DUP) >> (k)) & 1u))
#define PH_BEGIN(k) if (IN(k)) { for (int _rep = 0; _rep < DUPN(k); ++_rep) { if (_rep) xcd_barrier(bar);
#define PH_END(k) } } SEAM(k);

    const float* mod = (const float*)(ws + WS_MOD);
    const float* ONES = (const float*)(ws + WS_VEC); const float* ZEROS = ONES + D;
    float* RS = (float*)(ws + WS_RS); float* SLAB = (float*)(ws + WS_SLAB);
    _Float16* ZA = (_Float16*)(ws + WS_ZA); _Float16* ZB = (_Float16*)(ws + WS_ZB);
    bf16* H = (bf16*)(ws + WS_H); bf16* HID = (bf16*)(ws + WS_HID); bf16* PB = (bf16*)(ws + WS_HID); bf16* H8 = (bf16*)(ws + WS_H8);
    bf16* HF = F8_IN ? H8 : H;
    const bf16* W1T = (const bf16*)(ws + WS_W1T); const bf16* W2T = (const bf16*)(ws + WS_W2T);
    const float* lng = F.in[6]; const float* lnb = F.in[7];
    const int bx = (int)blockIdx.x;

#define MODP(layer, which) (mod + (size_t)((layer) * 2 + (which)) * NMOD)
#define GEMM_FFN_IN(k, mi, rows, cstage) PH_BEGIN(k) pg8::Gemm g{F8_IN ? (const void*)H8 : (const void*)H, (const unsigned char*)(ws + WS_W1T) + (size_t)(mi) * W1T_STRIDE * 2, F8_IN ? D : 2 * D, F8_IN ? D : 2 * D, 31, 0}; \
        pg8::StaticOrder S; S.init(rows, 2 * DFF, F8_IN ? D / 2 : D, F.G, bx); \
        pg8::EpiSwiglu<F8_IN, F8_OUT> E{HID, DFF}; pg8::gemm_phase<pg8::EpiSwiglu<F8_IN, F8_OUT>, pg8::StaticOrder, F8_IN>(F.lds + RING_OFF, g, S, E); \
        if ((cstage) > 0 && _rep == 0) { const int nbusy = S.nwg % F.G; if (bx >= nbusy) { conv_stage(F, cstage, (bx - nbusy) * NWAVES + F.wave, (F.G - nbusy) * NWAVES, 1); \
            if ((k) == 2) conv_stage(F, 0, (bx - nbusy) * NWAVES + F.wave, (F.G - nbusy) * NWAVES, 2); \
            if ((k) == 8) { __syncthreads(); LAS float* sv_ = (LAS float*)(F.lds + SVEC_OFF); for (int i_ = F.tid; i_ < 2 * D; i_ += NTHREADS) { const float x_ = (i_ < D) ? F.in[1][i_] : F.in[3][i_ - D]; sv_[i_] = pg8::fsilu(x_); } \
                __syncthreads(); mod_gemv(F, sv_, 1, MOD1_CUT, 72 * D, (bx - nbusy) * NWAVES + F.wave, (F.G - nbusy) * NWAVES); } } } PH_END(k)
#define FFN_OUT_GEMM pg8::Gemm g{HID, (const unsigned char*)(ws + WS_W2T) + (size_t)(mi_) * W2T_STRIDE * 2, F8_OUT ? DFF : 2 * DFF, F8_OUT ? DFF : 2 * DFF, 31, 0}
#define GEMM_FFN_OUT(k, mi, rows, zpl, zpc, lgp, lbp, layer, sub, zo) PH_BEGIN(k) const int mi_ = (mi); FFN_OUT_GEMM; pg8::StaticOrder S; S.init(rows, D, F8_OUT ? DFF / 2 : DFF, F.G, bx); \
        pg8::EpiResid<1, F8_OUT ? 11 : 0> E{zpl, zpc, 64, RS, lgp, lbp, MODP(layer, 0) + (size_t)((sub) * 3 + 2) * D, MODP(layer, 1) + (size_t)((sub) * 3 + 2) * D, nullptr, zo}; \
        pg8::gemm_phase<pg8::EpiResid<1, F8_OUT ? 11 : 0>, pg8::StaticOrder, F8_OUT>(F.lds + RING_OFF, g, S, E); PH_END(k)
#define GEMM_FFN_OUT_CTX(k, mi, zpl, ZF32K, lgp, lbp, layer, sub, zo) PH_BEGIN(k) const int mi_ = (mi); FFN_OUT_GEMM; pg8::SplitCtxOrder S; S.init2(SEQ, D, F8_OUT ? DFF / 2 : DFF, F.G, bx, 64, NSPLIT); \
        pg8::EpiResidSplit<1, F8_OUT ? 11 : 0, ZF32K> E{{zpl, zpl, 64, RS, lgp, lbp, MODP(layer, 0) + (size_t)((sub) * 3 + 2) * D, MODP(layer, 1) + (size_t)((sub) * 3 + 2) * D, nullptr, zo}, SLAB, F8_OUT ? DFF / 128 : DFF / 64}; \
        pg8::gemm_phase<pg8::EpiResidSplit<1, F8_OUT ? 11 : 0, ZF32K>, pg8::SplitCtxOrder, F8_OUT>(F.lds + RING_OFF, g, S, E); \
        if (_rep == 0 && bx >= 8 * NSPLIT) conv_stage(F, (k) == 3 ? 1 : ((k) == 9 ? 2 : 3), (bx - 8 * NSPLIT) * NWAVES + F.wave, (F.G - 8 * NSPLIT) * NWAVES, 2); PH_END(k)

    PH_BEGIN(0) p0_prologue(F, _rep == 0); PH_END(0)
    PH_BEGIN(1) t_rows<0, false, F8_IN>(F, F.in[0], F.in[2], nullptr, nullptr, MODP(0, 0), MODP(0, 1), 0, HF, nullptr, RS, MALL); PH_END(1)
    GEMM_FFN_IN(2, 0, MALL, 1)
    GEMM_FFN_OUT_CTX(3, 0, F.in[0], true, ONES, ZEROS, 0, 0, ZA)
    PH_BEGIN(4) t_rows<1, true, false, true>(F, ZA, ZA + (size_t)SEQ * D, lng + 0 * D, lnb + 0 * D, MODP(0, 0), MODP(0, 1), 1, H, nullptr, RS, MALL, CtxComb{SLAB, F.in[2], ONES, ZEROS, MODP(0, 1) + (size_t)(0 * 3 + 2) * D, ZA + (size_t)SEQ * D}); PH_END(4)
    PH_BEGIN(5) tp_pool(F, H, PB); PH_END(5)
    PH_BEGIN(6) { pg8::Gemm g{PB, (const bf16*)(ws + WS_WPT), 2 * D, 2 * 512, 1, 2 * 512}; pg8::StaticOrder S; S.init(MALL, D, 512, F.G, bx);
        pg8::EpiResid<2> E{ZA, ZA + (size_t)SEQ * D, 64, RS, lng + 0 * D, lnb + 0 * D, MODP(0, 0) + (size_t)(1 * 3 + 2) * D, MODP(0, 1) + (size_t)(1 * 3 + 2) * D, F.in[11], ZB};
        pg8::gemm_phase<pg8::EpiResid<2>, pg8::StaticOrder>(F.lds + RING_OFF, g, S, E);
        if (_rep == 0) { const int nbusy = S.nwg % F.G; if (bx >= nbusy) {
            LAS float* sv = (LAS float*)(F.lds + SVEC_OFF);
            for (int i = F.tid; i < 2 * D; i += NTHREADS) { const float x = (i < D) ? F.in[1][i] : F.in[3][i - D]; sv[i] = pg8::fsilu(x); }
            __syncthreads();
            mod_gemv(F, sv, 1, 0, MOD1_CUT, (bx - nbusy) * NWAVES + F.wave, (F.G - nbusy) * NWAVES); } } }
    PH_END(6)
    PH_BEGIN(7) t_rows<1, false, F8_IN>(F, ZB, ZB + (size_t)SEQ * D, lng + 1 * D, lnb + 1 * D, MODP(0, 0), MODP(0, 1), 2, HF, nullptr, RS, MALL); PH_END(7)
    GEMM_FFN_IN(8, 1, MALL, 2)
    GEMM_FFN_OUT_CTX(9, 1, ZB, false, lng + 1 * D, lnb + 1 * D, 0, 2, ZA)
    PH_BEGIN(10) t_rows<1, true, F8_IN>(F, ZA, ZA + (size_t)SEQ * D, lng + 2 * D, lnb + 2 * D, MODP(1, 0), MODP(1, 1), 0, HF, nullptr, RS, MALL, CtxComb{SLAB, ZB + (size_t)SEQ * D, lng + 1 * D, lnb + 1 * D, MODP(0, 1) + (size_t)(2 * 3 + 2) * D, ZA + (size_t)SEQ * D}); PH_END(10)
    GEMM_FFN_IN(11, 2, MALL, 3)
    GEMM_FFN_OUT_CTX(12, 2, ZA, false, lng + 2 * D, lnb + 2 * D, 1, 0, ZB)
    PH_BEGIN(13) t_rows<1, true>(F, ZB, ZB + (size_t)SEQ * D, lng + 3 * D, lnb + 3 * D, MODP(1, 0), MODP(1, 1), 1, H, nullptr, RS, MALL, CtxComb{SLAB, ZA + (size_t)SEQ * D, lng + 2 * D, lnb + 2 * D, MODP(1, 1) + (size_t)(0 * 3 + 2) * D, ZB + (size_t)SEQ * D}); PH_END(13)
    ScanT ST;
    ST.Q = (const bf16*)(ws + WS_Q); ST.V = (const bf16*)(ws + WS_V); ST.G0 = (const unsigned short*)(ws + WS_GF); ST.G1 = (const unsigned short*)(ws + WS_GB); ST.OG = (const bf16*)(ws + WS_OG);
    ST.OF = (float*)(ws + WS_HID); ST.YG = H; ST.ST = (float*)(ws + WS_ST); ST.CST = (float*)(ws + WS_CST); ST.DT = (float*)(ws + WS_DT); ST.normg = F.in[14];
    PH_BEGIN(14) { pg8::Gemm g{H, (const bf16*)(ws + WS_WHI), 2 * D, 2 * D, 31, 0}; pg8::StaticOrder S; S.init(MALL, 5 * D, D, F.G, bx);
        pg8::EpiHgrn E{(bf16*)(ws + WS_Q), (bf16*)(ws + WS_V), (unsigned short*)(ws + WS_GF), (unsigned short*)(ws + WS_GB), (bf16*)(ws + WS_OG), F.in[13], D};
        pg8::gemm_phase<pg8::EpiHgrn, pg8::StaticOrder>(F.lds + RING_OFF, g, S, E);
        if (_rep == 0) { const int nbusy = S.nwg % F.G; if (bx >= nbusy) conv_stage(F, 4, (bx - nbusy) * NWAVES + F.wave, (F.G - nbusy) * NWAVES); } }
    PH_END(14)
    PH_BEGIN(15) {
#pragma unroll 1
        for (int u = bx; u < 544; u += F.G) {
            if (u < 512) { const int hd = u >> 4, seg = u & 15, h = hd >> 1, dir = hd & 1;
                scan_state_unit(F, ST, h, dir, dir ? seg * SEGLEN + SEGLEN - CHUNK : seg * SEGLEN, dir ? -CHUNK : CHUNK, SEGLEN / CHUNK, ST.ST + (size_t)(hd * NSEG + seg) * 16384, ST.DT + (size_t)(hd * NSEG + seg) * 128);
            } else { const int hd = u - 512, h = hd >> 1, dir = hd & 1;
                scan_state_unit(F, ST, h, dir, dir ? SEQ + CTXL - CHUNK : SEQ, dir ? -CHUNK : CHUNK, CTXL / CHUNK, ST.CST + (size_t)hd * 16384, nullptr); }
        }
    }
    PH_END(15)
    PH_BEGIN(16) {
        for (int gt = bx * NTHREADS + F.tid; gt < 32 * 4096; gt += F.G * NTHREADS) {
            const int hd = gt >> 12, e4 = (gt & 4095) * 4, dir = hd & 1;
            const int tr = (e4 >> 6) & 31, ln = e4 & 63, k = 16 * (tr >> 2) + 4 * (ln >> 4) + (tr & 3);
            f32x4 carry = *(const f32x4*)(ST.CST + (size_t)hd * 16384 + e4);
            f32x4 tmp[NSEG]; float dcy[NSEG];
#pragma unroll
            for (int j = 0; j < NSEG; ++j) { const int seg = dir ? (NSEG - 1 - j) : j; tmp[j] = *(const f32x4*)(ST.ST + (size_t)(hd * NSEG + seg) * 16384 + e4); dcy[j] = ST.DT[(size_t)(hd * NSEG + seg) * 128 + k]; }
#pragma unroll
            for (int j = 0; j < NSEG; ++j) { const int seg = dir ? (NSEG - 1 - j) : j; *(f32x4*)(ST.ST + (size_t)(hd * NSEG + seg) * 16384 + e4) = carry; carry = carry * dcy[j] + tmp[j]; }
        }
    }
    PH_END(16)
    PH_BEGIN(17) {
#pragma unroll 1
        for (int u = bx; u < 256; u += F.G) { const int h = u >> 4, seg = u & 15;
            scan_unit<true>(F, ST, h, 0, seg * SEGLEN, CHUNK, SEGLEN / CHUNK, ST.ST + (size_t)((h * 2 + 0) * NSEG + seg) * 16384, nullptr, nullptr);
            VM_WAIT(); __syncthreads();
            scan_unit<true>(F, ST, h, 1, seg * SEGLEN + SEGLEN - CHUNK, -CHUNK, SEGLEN / CHUNK, ST.ST + (size_t)((h * 2 + 1) * NSEG + seg) * 16384, nullptr, nullptr); }
    }
    PH_END(17)
    PH_BEGIN(18) { pg8::Gemm g{H, (const bf16*)(ws + WS_WHO), 2 * D, 2 * D, 31, 0}; pg8::StaticOrder S; S.init(SEQ, D, D, F.G, bx);
        pg8::EpiResid<2> E{ZB, ZB + (size_t)SEQ * D, 64, RS, lng + 3 * D, lnb + 3 * D, MODP(1, 0) + (size_t)(1 * 3 + 2) * D, MODP(1, 1) + (size_t)(1 * 3 + 2) * D, nullptr, ZA};
        pg8::gemm_phase<pg8::EpiResid<2>, pg8::StaticOrder>(F.lds + RING_OFF, g, S, E); }
    PH_END(18)
    PH_BEGIN(19) t_rows<1, false, F8_IN>(F, ZA, ZA + (size_t)SEQ * D, lng + 4 * D, lnb + 4 * D, MODP(1, 0), MODP(1, 1), 2, HF, nullptr, RS, SEQ); PH_END(19)
    GEMM_FFN_IN(20, 3, SEQ, 0)
    GEMM_FFN_OUT(21, 3, SEQ, ZA, ZA + (size_t)SEQ * D, lng + 4 * D, lnb + 4 * D, 1, 2, ZB)
    PH_BEGIN(22) t_rows<2>(F, ZB, ZB + (size_t)SEQ * D, lng + 5 * D, lnb + 5 * D, nullptr, nullptr, 0, nullptr, F.out, RS, SEQ); } }
#undef IN
#undef SEAM
}

#ifndef MK_CUTS
#define MK_CUTS 0
#endif
extern "C" void kernel_launch(void* const* d_in, const int* in_sizes, int n_in, void* d_out, int out_size, void* d_ws, size_t ws_size, hipStream_t stream) {
    static int grid = 0;
    if (grid == 0) {
        if (n_in != 16 || out_size != SEQ * D || ws_size < WS_END) { fprintf(stderr, "kernel_launch: unexpected shapes (n_in %d out %d ws %zu)\n", n_in, out_size, ws_size); grid = -1; return; }
        int dev = 0, cus = 0, per_cu = 0;
        if (hipGetDevice(&dev) != hipSuccess || hipDeviceGetAttribute(&cus, hipDeviceAttributeMultiprocessorCount, dev) != hipSuccess) { grid = -1; return; }
        if (hipFuncSetAttribute((const void*)mk_fwd, hipFuncAttributeMaxDynamicSharedMemorySize, LDS_BYTES) != hipSuccess) { fprintf(stderr, "kernel_launch: hipFuncSetAttribute failed\n"); grid = -1; return; }
        if (hipOccupancyMaxActiveBlocksPerMultiprocessor(&per_cu, (const void*)mk_fwd, NTHREADS, LDS_BYTES) != hipSuccess || per_cu < 1) { fprintf(stderr, "kernel_launch: occupancy query says %d\n", per_cu); }
        (void)hipGetLastError();
        grid = cus;
    }
    if (grid < 0) return;
    (void)hipMemsetAsync((char*)d_ws + WS_CTL, 0, CTL_ZERO_BYTES, stream);
    Args a{};
    for (int i = 0; i < 16; ++i) a.in[i] = (const float*)d_in[i];
    a.out = (float*)d_out; a.ws = (unsigned char*)d_ws;
#if MK_CUTS
    for (int p = 0; p < NPHASES; ++p) { a.ph_lo = p; a.ph_hi = p + 1; hipLaunchKernelGGL(mk_fwd, dim3(grid), dim3(NTHREADS), LDS_BYTES, stream, a); }
#else
    a.ph_lo = 0; a.ph_hi = NPHASES;
    hipLaunchKernelGGL(mk_fwd, dim3(grid), dim3(NTHREADS), LDS_BYTES, stream, a);
#endif
}
```
